# Optimizing an MI355X kernel written in HIP

```python
import math, functools
import jax, jax.numpy as jnp
from jax import lax
import numpy as np

D_MODEL = 1024
BATCH = 16
SEQ = 2048
DEPTH = 1
DEC_BATCH = 128
DEC_SEQ = 1
PAST_LEN = 8192
PAGE_SIZE = 128

GLA_HEADS = 4
GLA_DK = 64
GLA_DV = 128
GLA_GATE_RANK = 16
GLA_GATE_NORM = 16.0
GLA_CHUNK = 64
MLA_HEADS = 4
MLA_NOPE = 128
MLA_ROPE = 64
MLA_V = 128
MLA_Q_RANK = 256
MLA_KV_RANK = 128
ROPE_THETA = 10000.0
Q_BLOCK = 128
MLA_SCALE = 1.0 / math.sqrt(MLA_NOPE + MLA_ROPE)
D_FF = 2816
EPS = 1e-6

GLA_WIDTH = GLA_HEADS * GLA_DV
MLA_WIDTH = MLA_HEADS * MLA_V
MIX_WIDTH = GLA_WIDTH + MLA_WIDTH
IN_SPLITS = (GLA_HEADS * GLA_DK, GLA_HEADS * GLA_DK, GLA_WIDTH, GLA_WIDTH, GLA_GATE_RANK,
             MLA_Q_RANK, MLA_KV_RANK, MLA_ROPE)
IN_WIDTH = sum(IN_SPLITS)

kernel_name = "hymba_gla_mla_macaron_step"


def rms_norm(x, w):
    xf = x.astype(jnp.float32)
    y = xf * lax.rsqrt(jnp.mean(xf * xf, axis=-1, keepdims=True) + EPS)
    return (y * w.astype(jnp.float32)).astype(x.dtype)


def swiglu(x, w_gate, w_up, w_down):
    return (jax.nn.silu(x @ w_gate) * (x @ w_up)) @ w_down


def rope(x, pos):
    half = MLA_ROPE // 2
    inv_freq = jnp.power(jnp.float32(ROPE_THETA), -jnp.arange(half, dtype=jnp.float32) / half)
    ang = pos.astype(jnp.float32)[:, None] * inv_freq[None, :]
    cos = jnp.cos(ang)[None, :, None, :]
    sin = jnp.sin(ang)[None, :, None, :]
    xf = x.astype(jnp.float32)
    x1, x2 = xf[..., :half], xf[..., half:]
    return jnp.concatenate([x1 * cos - x2 * sin, x1 * sin + x2 * cos], axis=-1).astype(x.dtype)


def gla_inputs(q, k, v, a_low, w_a_up, b_a):
    B, T = q.shape[:2]
    def to_heads(t, d):
        return t.reshape(B, T, GLA_HEADS, d).transpose(0, 2, 1, 3)
    log_a = jax.nn.log_sigmoid((a_low @ w_a_up + b_a).astype(jnp.float32)) / GLA_GATE_NORM
    return (to_heads(q, GLA_DK) * (GLA_DK ** -0.5), to_heads(k, GLA_DK),
            to_heads(v, GLA_DV), to_heads(log_a, GLA_DK))


def gla_chunk(S, q, k, v, log_a):
    C = q.shape[2]
    b = jnp.cumsum(log_a, axis=2)
    causal = jnp.tril(jnp.ones((C, C), dtype=bool))
    diff = b[:, :, :, None, :] - b[:, :, None, :, :]
    decay = jnp.exp(jnp.where(causal[:, :, None], diff, -jnp.inf))
    attn = jnp.einsum('bhid,bhjd,bhijd->bhij', q, k, decay)
    o = (jnp.einsum('bhij,bhjv->bhiv', attn, v)
         + jnp.einsum('bhid,bhdv->bhiv', q * jnp.exp(b), S))
    b_last = b[:, :, -1:, :]
    S_new = (jnp.exp(b_last[:, :, 0, :])[..., None] * S
             + jnp.einsum('bhjd,bhjv->bhdv', k * jnp.exp(b_last - b), v))
    return S_new.astype(jnp.float32), o.astype(jnp.float32)


def gla_prompt(q, k, v, log_a):
    B, H, T, _ = q.shape
    n = T // GLA_CHUNK
    def chunks(t):
        return t.reshape(B, H, n, GLA_CHUNK, t.shape[-1]).transpose(2, 0, 1, 3, 4)
    S0 = jnp.zeros((B, H, GLA_DK, GLA_DV), jnp.float32)
    S, o = lax.scan(lambda s, c: gla_chunk(s, *c), S0, (chunks(q), chunks(k), chunks(v), chunks(log_a)))
    o = o.transpose(1, 2, 0, 3, 4).reshape(B, H, T, GLA_DV)
    return o, S


def gla_sample(S0, q, k, v, log_a):
    S, o = gla_chunk(S0.astype(jnp.float32), q, k, v, log_a)
    return o, S


def gla_output(o, g, norm_w):
    B, H, T, _ = o.shape
    o = rms_norm(o.transpose(0, 2, 1, 3), norm_w)
    return (o * jax.nn.silu(g.astype(jnp.float32)).reshape(B, T, H, GLA_DV)).reshape(B, T, GLA_WIDTH).astype(g.dtype)


def mla_project(c_q, c_kv, k_pe_raw, pos, q_norm_w, kv_norm_w, w_uq):
    B, T = c_q.shape[:2]
    q = (rms_norm(c_q, q_norm_w) @ w_uq).reshape(B, T, MLA_HEADS, MLA_NOPE + MLA_ROPE)
    q_nope = q[..., :MLA_NOPE]
    q_pe = rope(q[..., MLA_NOPE:], pos)
    lat = rms_norm(c_kv, kv_norm_w)
    k_pe = rope(k_pe_raw[:, :, None, :], pos)[:, :, 0, :]
    return q_nope, q_pe, lat, k_pe


def mla_prompt_attention(q_nope, q_pe, lat, k_pe, w_uk, w_uv):
    B, T = q_nope.shape[:2]
    k_nope = jnp.einsum('btc,chd->bthd', lat, w_uk)
    v = jnp.einsum('btc,chd->bthd', lat, w_uv)
    nb = T // Q_BLOCK
    qn_b = q_nope.reshape(B, nb, Q_BLOCK, MLA_HEADS, MLA_NOPE).transpose(1, 0, 2, 3, 4)
    qp_b = q_pe.reshape(B, nb, Q_BLOCK, MLA_HEADS, MLA_ROPE).transpose(1, 0, 2, 3, 4)
    starts = jnp.arange(nb, dtype=jnp.int32) * Q_BLOCK
    kpos = jnp.arange(T, dtype=jnp.int32)

    def block(args):
        qn, qp, start = args
        s = (jnp.einsum('bqhd,bkhd->bhqk', qn, k_nope)
             + jnp.einsum('bqhr,bkr->bhqk', qp, k_pe)).astype(jnp.float32) * MLA_SCALE
        qpos = start + jnp.arange(Q_BLOCK, dtype=jnp.int32)
        s = jnp.where(kpos[None, :] <= qpos[:, None], s, -jnp.inf)
        p = jax.nn.softmax(s, axis=-1)
        return jnp.einsum('bhqk,bkhd->bqhd', p.astype(v.dtype), v)

    o = lax.map(block, (qn_b, qp_b, starts))
    return o.transpose(1, 0, 2, 3, 4).reshape(B, T, MLA_WIDTH)


def mla_sample_attention(past_lat, past_pe, q_nope, q_pe, lat, k_pe, w_uk, w_uv):
    B, T = q_nope.shape[:2]
    past_len = past_lat.shape[1]
    lat_all = jnp.concatenate([past_lat.astype(lat.dtype), lat], axis=1)
    pe_all = jnp.concatenate([past_pe.astype(k_pe.dtype), k_pe], axis=1)
    q_lat = jnp.einsum('bqhd,chd->bqhc', q_nope, w_uk)
    s = (jnp.einsum('bqhc,bkc->bhqk', q_lat, lat_all)
         + jnp.einsum('bqhr,bkr->bhqk', q_pe, pe_all)).astype(jnp.float32) * MLA_SCALE
    kpos = jnp.arange(lat_all.shape[1], dtype=jnp.int32)
    qpos = past_len + jnp.arange(T, dtype=jnp.int32)
    s = jnp.where(kpos[None, :] <= qpos[:, None], s, -jnp.inf)
    p = jax.nn.softmax(s, axis=-1)
    o_lat = jnp.einsum('bhqk,bkc->bqhc', p.astype(lat_all.dtype), lat_all)
    return jnp.einsum('bqhc,chd->bqhd', o_lat, w_uv).reshape(B, T, MLA_WIDTH)


def hybrid_layer(x, pos, lw, gla_mix, mla_attend):
    (f1n, f1g, f1u, f1d, mix_n, w_in, w_a_up, b_a, g_norm, q_norm, w_uq, kv_norm,
     w_uk, w_uv, w_out, f2n, f2g, f2u, f2d) = lw
    x = x + 0.5 * swiglu(rms_norm(x, f1n), f1g, f1u, f1d)
    h = rms_norm(x, mix_n)
    offsets = [int(o) for o in np.cumsum(IN_SPLITS)[:-1]]
    q, k, v, g, a_low, c_q, c_kv, k_pe_raw = jnp.split(h @ w_in, offsets, axis=-1)
    o_gla, S = gla_mix(*gla_inputs(q, k, v, a_low, w_a_up, b_a))
    y_gla = gla_output(o_gla, g, g_norm)
    q_nope, q_pe, lat, k_pe = mla_project(c_q, c_kv, k_pe_raw, pos, q_norm, kv_norm, w_uq)
    y_mla = mla_attend(q_nope, q_pe, lat, k_pe, w_uk, w_uv)
    x = x + jnp.concatenate([y_gla, y_mla], axis=-1) @ w_out
    x = x + 0.5 * swiglu(rms_norm(x, f2n), f2g, f2u, f2d)
    return x, lat, k_pe, S


def setup_inputs(seed: int = 0) -> dict:
    key = jax.random.key(seed)
    ks = iter(jax.random.split(key, 40))
    N_PAGES = PAST_LEN // PAGE_SIZE
    N_POOL = (DEC_BATCH * N_PAGES * 5) // 4
    f32 = jnp.float32

    def nrm(shape, scale):
        return jax.random.normal(next(ks), shape, f32) * scale

    def gain(shape):
        return 1.0 + 0.01 * jax.random.normal(next(ks), shape, f32)

    x_prompt = jax.random.normal(next(ks), (BATCH, SEQ, D_MODEL), f32)
    x_sample = jax.random.normal(next(ks), (DEC_BATCH, DEC_SEQ, D_MODEL), f32)
    cache_kv = jax.random.normal(next(ks), (DEPTH, N_POOL, PAGE_SIZE, MLA_KV_RANK), f32)
    cache_pe = jax.random.normal(next(ks), (DEPTH, N_POOL, PAGE_SIZE, MLA_ROPE), f32)
    state_gla = nrm((DEPTH, DEC_BATCH, GLA_HEADS, GLA_DK, GLA_DV), 0.5)
    page_table = jax.random.permutation(next(ks), N_POOL)[:DEC_BATCH * N_PAGES].reshape(
        DEC_BATCH, N_PAGES).astype(jnp.int32)
    return {
        "x_prompt": x_prompt,
        "x_sample": x_sample,
        "cache_kv": cache_kv,
        "cache_pe": cache_pe,
        "state_gla": state_gla,
        "page_table": page_table,
        "ffn1_norm_w": gain((DEPTH, D_MODEL)),
        "ffn1_w_gate": nrm((DEPTH, D_MODEL, D_FF), D_MODEL ** -0.5),
        "ffn1_w_up": nrm((DEPTH, D_MODEL, D_FF), D_MODEL ** -0.5),
        "ffn1_w_down": nrm((DEPTH, D_FF, D_MODEL), D_FF ** -0.5),
        "mix_norm_w": gain((DEPTH, D_MODEL)),
        "w_in": nrm((DEPTH, D_MODEL, IN_WIDTH), D_MODEL ** -0.5),
        "gla_w_a_up": nrm((DEPTH, GLA_GATE_RANK, GLA_HEADS * GLA_DK), GLA_GATE_RANK ** -0.5),
        "gla_b_a": nrm((DEPTH, GLA_HEADS * GLA_DK), 0.1),
        "gla_norm_w": gain((DEPTH, GLA_DV)),
        "mla_q_norm_w": gain((DEPTH, MLA_Q_RANK)),
        "mla_w_uq": nrm((DEPTH, MLA_Q_RANK, MLA_HEADS * (MLA_NOPE + MLA_ROPE)), MLA_Q_RANK ** -0.5),
        "mla_kv_norm_w": gain((DEPTH, MLA_KV_RANK)),
        "mla_w_uk": nrm((DEPTH, MLA_KV_RANK, MLA_HEADS, MLA_NOPE), MLA_KV_RANK ** -0.5),
        "mla_w_uv": nrm((DEPTH, MLA_KV_RANK, MLA_HEADS, MLA_V), MLA_KV_RANK ** -0.5),
        "w_out": nrm((DEPTH, MIX_WIDTH, D_MODEL), MIX_WIDTH ** -0.5),
        "ffn2_norm_w": gain((DEPTH, D_MODEL)),
        "ffn2_w_gate": nrm((DEPTH, D_MODEL, D_FF), D_MODEL ** -0.5),
        "ffn2_w_up": nrm((DEPTH, D_MODEL, D_FF), D_MODEL ** -0.5),
        "ffn2_w_down": nrm((DEPTH, D_FF, D_MODEL), D_FF ** -0.5),
        "final_norm_w": gain((D_MODEL,)),
    }


def reference(x_prompt, x_sample, cache_kv, cache_pe, state_gla, page_table,
              ffn1_norm_w, ffn1_w_gate, ffn1_w_up, ffn1_w_down, mix_norm_w, w_in,
              gla_w_a_up, gla_b_a, gla_norm_w, mla_q_norm_w, mla_w_uq, mla_kv_norm_w,
              mla_w_uk, mla_w_uv, w_out, ffn2_norm_w, ffn2_w_gate, ffn2_w_up, ffn2_w_down,
              final_norm_w):
    B_s, T_s = x_sample.shape[:2]
    pos_prompt = jnp.arange(x_prompt.shape[1], dtype=jnp.int32)
    pos_sample = PAST_LEN + jnp.arange(T_s, dtype=jnp.int32)
    layer_weights = (ffn1_norm_w, ffn1_w_gate, ffn1_w_up, ffn1_w_down, mix_norm_w, w_in,
                     gla_w_a_up, gla_b_a, gla_norm_w, mla_q_norm_w, mla_w_uq, mla_kv_norm_w,
                     mla_w_uk, mla_w_uv, w_out, ffn2_norm_w, ffn2_w_gate, ffn2_w_up, ffn2_w_down)
    xp, xs = x_prompt, x_sample
    lat_p, pe_p, gla_p, lat_s, pe_s, gla_s = [], [], [], [], [], []
    for l in range(DEPTH):
        lw = tuple(w[l] for w in layer_weights)
        xp, lat, kpe, S = hybrid_layer(xp, pos_prompt, lw, gla_prompt, mla_prompt_attention)
        lat_p.append(lat); pe_p.append(kpe); gla_p.append(S)
        past_lat = cache_kv[l, page_table].reshape(B_s, -1, MLA_KV_RANK)
        past_pe = cache_pe[l, page_table].reshape(B_s, -1, MLA_ROPE)
        xs, lat, kpe, S = hybrid_layer(
            xs, pos_sample, lw,
            functools.partial(gla_sample, state_gla[l]),
            functools.partial(mla_sample_attention, past_lat, past_pe))
        lat_s.append(lat); pe_s.append(kpe); gla_s.append(S)
    y_prompt = rms_norm(xp, final_norm_w)
    y_sample = rms_norm(xs, final_norm_w)
    new_kv_prompt = jnp.stack(lat_p)
    new_pe_prompt = jnp.stack(pe_p)
    new_gla_prompt = jnp.stack(gla_p)
    new_kv_sample = jnp.stack(lat_s)
    new_pe_sample = jnp.stack(pe_s)
    new_gla_sample = jnp.stack(gla_s)
    return (y_prompt, y_sample, new_kv_prompt, new_pe_prompt, new_gla_prompt,
            new_kv_sample, new_pe_sample, new_gla_sample)
```

```cpp
#include <hip/hip_runtime.h>
#include <cstdio>
#include <cstdint>

#ifndef MK_ONE_LAUNCH
#define MK_ONE_LAUNCH 1
#endif

constexpr int DM = 1024, BATCH = 16, SEQ = 2048, DECB = 128, PAST = 8192, PAGE = 128, NPAGES = PAST / PAGE;
constexpr int DFF = 2816, INW = 2000;
constexpr int MP = BATCH * SEQ, MS = DECB, MT = MP + MS;
constexpr int MPAD = 33024, PAD_PM = 128;
constexpr float EPS = 1e-6f;
constexpr float MLA_SCALE = 0.07216878364870322f;
constexpr int C_Q = 0, C_K = 256, C_V = 512, C_G = 1024, C_A = 1536, C_CQ = 1552, C_CKV = 1808, C_KPE = 1936;
constexpr size_t O_YP = 0, O_YS = (size_t)MP * DM, O_KVP = O_YS + (size_t)MS * DM, O_PEP = O_KVP + (size_t)MP * 128, O_GLP = O_PEP + (size_t)MP * 64,
                 O_KVS = O_GLP + (size_t)BATCH * 4 * 64 * 128, O_PES = O_KVS + (size_t)MS * 128, O_GLS = O_PES + (size_t)MS * 64, O_END = O_GLS + (size_t)MS * 4 * 64 * 128;

constexpr size_t al256(size_t x) { return (x + 255) & ~(size_t)255; }
constexpr size_t WS_CTL_BYTES = 1u << 20;
constexpr size_t B_WGU1 = WS_CTL_BYTES, B_WD1 = B_WGU1 + (size_t)5632 * 1024 * 2, B_WIN = B_WD1 + (size_t)1024 * 2816 * 2, B_WOUT = B_WIN + (size_t)2048 * 1024 * 2,
                 B_WGU2 = B_WOUT + (size_t)1024 * 1024 * 2, B_WD2 = B_WGU2 + (size_t)5632 * 1024 * 2, B_XB = B_WD2 + (size_t)1024 * 2816 * 2,
                 B_SSQ0 = B_XB + (size_t)MPAD * DM * 2, B_H = al256(B_SSQ0 + (size_t)MPAD * 4), B_X1 = B_H + (size_t)MPAD * DFF * 2, B_X1B = B_X1 + (size_t)MPAD * DM * 4,
                 B_SSQ1 = B_X1B + (size_t)MPAD * DM * 2, B_X2 = B_SSQ1 + (size_t)MPAD * 64, B_X2B = B_X2 + (size_t)MPAD * DM * 4, B_SSQ2 = B_X2B + (size_t)MPAD * DM * 2,
                 B_X3 = B_SSQ2 + (size_t)MPAD * 64, B_X3B = B_X3 + (size_t)MPAD * DM * 4, B_SSQ3 = B_X3B + (size_t)MPAD * DM * 2, B_YMIXB = B_SSQ3 + (size_t)MPAD * 64,
                 B_PROJ = B_YMIXB + (size_t)MPAD * DM * 2, B_OG = B_PROJ + (size_t)MT * INW * 4, B_QF = B_OG + (size_t)MT * 512 * 4, B_LAT = B_QF + (size_t)MT * 768 * 4,
                 B_KPE = B_LAT + (size_t)MT * 128 * 4, B_KN = B_KPE + (size_t)MT * 64 * 4, B_VV = B_KN + (size_t)MT * 512 * 4, B_CQN = B_VV + (size_t)MT * 512 * 4,
                 B_QLAT = B_CQN + (size_t)MT * 256 * 4, B_OLAT = B_QLAT + (size_t)MS * 512 * 4,
                 B_WQA = al256(B_OLAT + (size_t)MS * 512 * 4), B_RT = B_WQA + (size_t)768 * 256 * 2, B_CQB = al256(B_RT + (size_t)2049 * 32 * 8), B_CQS = B_CQB + (size_t)MPAD * 256 * 2,
                 B_CKV = B_CQS + (size_t)MPAD * 16, B_KPR = B_CKV + (size_t)MPAD * 128 * 4, B_KL = B_KPR + (size_t)MPAD * 64 * 4, B_QA = B_KL + (size_t)MPAD * 192 * 2,
                 B_QG = B_QA + (size_t)MPAD * 768 * 2, B_KG = B_QG + (size_t)MPAD * 256 * 2, B_VT = B_KG + (size_t)MPAD * 256 * 2, B_VS = B_VT + (size_t)64 * 128 * 2048 * 2,
                 B_SG = B_VS + (size_t)MS * 512 * 4, B_ALOW = B_SG + (size_t)MPAD * 512 * 2, B_DEC = B_ALOW + (size_t)MPAD * 16 * 4, B_UT = B_DEC + (size_t)2048 * 64 * 4,
                 B_ST = B_UT + (size_t)2048 * 128 * 64 * 4, B_PART = B_ST + (size_t)2048 * 128 * 64 * 2, B_END = B_PART + (size_t)256 * 4 * 132 * 4;

#define LAS __attribute__((address_space(3)))
constexpr int NTHR = 512;
constexpr int LDS_BYTES = 147456;
constexpr int MISC_OFF = 147456 - 256;

#define XB_TMO      128
#define XB_XCNT(j)  (256  + 64 * (j))
#define XB_XSUB(j)  (1280 + 64 * (j))
#define XB_XGEN(j)  (2304 + 64 * (j))
#define XB_TOP      3328
#define XB_TOPGEN   3392
#define XCD_BAR_WORDS 3456
#define XB_SPIN_CAP (1u << 25)
__device__ __forceinline__ unsigned xb_ld(unsigned* p)              { return __hip_atomic_load(p, __ATOMIC_RELAXED, __HIP_MEMORY_SCOPE_AGENT); }
__device__ __forceinline__ unsigned xb_add(unsigned* p, unsigned v) { return __hip_atomic_fetch_add(p, v, __ATOMIC_RELAXED, __HIP_MEMORY_SCOPE_AGENT); }
__device__ __forceinline__ unsigned xb_xcc_id() { return (unsigned)__builtin_amdgcn_s_getreg((3 << 11) | 20) & 0xFu; }
#define XB_SPIN(cond, bar) do { unsigned _sp = 0; while (cond) { __builtin_amdgcn_s_sleep(1); \
    if ((++_sp & 255u) == 0u) { if (xb_ld(&(bar)[XB_TMO])) break; if (_sp > XB_SPIN_CAP) { atomicAdd(&(bar)[XB_TMO], 1u); break; } } } } while (0)
struct XcdBarrier { unsigned* bar; unsigned x; volatile LAS unsigned* st; };
__device__ __forceinline__ XcdBarrier xcd_barrier_post(unsigned* bar, volatile LAS unsigned* st) {
    XcdBarrier b; b.bar = bar; b.x = xb_xcc_id(); b.st = st;
    if (threadIdx.x == 0) (void)xb_add(&bar[XB_XCNT(b.x)], 1u);
    return b;
}
__device__ __forceinline__ void xcd_barrier_complete(unsigned* bar, unsigned x, unsigned& nloc, unsigned& nx) {
    const unsigned G = gridDim.x * gridDim.y * gridDim.z;
    unsigned sum, cnt, mine, sp = 0u;
    for (;;) {
        sum = 0u; cnt = 0u; mine = 0u;
#pragma unroll
        for (unsigned j = 0; j < 16; ++j) { const unsigned c = xb_ld(&bar[XB_XCNT(j)]); sum += c; cnt += (c > 0u) ? 1u : 0u; mine = (j == x) ? c : mine; }
        if (sum == G) break;
        __builtin_amdgcn_s_sleep(1);
        if ((++sp & 255u) == 0u) { if (xb_ld(&bar[XB_TMO])) break; if (sp > XB_SPIN_CAP) { atomicAdd(&bar[XB_TMO], 1u); break; } }
    }
    nloc = mine > 0u ? mine : 1u; nx = cnt > 0u ? cnt : 1u;
}
__device__ __forceinline__ void xcd_barrier(const XcdBarrier& b) {
    asm volatile("s_waitcnt vmcnt(0)" ::: "memory");
    __syncthreads();
    if (threadIdx.x == 0) {
        unsigned* bar = b.bar;
        __builtin_amdgcn_s_waitcnt(0);
        unsigned nloc = b.st[0], nx = b.st[1];
        if (nloc == 0u) { xcd_barrier_complete(bar, b.x, nloc, nx); b.st[0] = nloc; b.st[1] = nx; }
        const unsigned old = xb_add(&bar[XB_XSUB(b.x)], 1u);
        const unsigned gen = old / nloc;
        if (old + 1u == (gen + 1u) * nloc) {
            __builtin_amdgcn_fence(__ATOMIC_RELEASE, "agent");
            asm volatile("s_waitcnt vmcnt(0)" ::: "memory");
            const unsigned og = xb_add(&bar[XB_TOP], 1u);
            const unsigned tg = og / nx;
            if (og + 1u == (tg + 1u) * nx) xb_add(&bar[XB_TOPGEN], 1u);
            else XB_SPIN(xb_ld(&bar[XB_TOPGEN]) == tg, bar);
            __builtin_amdgcn_fence(__ATOMIC_ACQUIRE, "agent");
            xb_add(&bar[XB_XGEN(b.x)], 1u);
            asm volatile("s_waitcnt vmcnt(0)" ::: "memory");
        } else {
            XB_SPIN(xb_ld(&bar[XB_XGEN(b.x)]) == gen, bar);
            __builtin_amdgcn_fence(__ATOMIC_ACQUIRE, "agent");
            asm volatile("s_waitcnt vmcnt(0)" ::: "memory");
        }
    }
    __syncthreads();
}

namespace pg8 {
#define PG8_LAS __attribute__((address_space(3)))
typedef unsigned short bf16_t;
typedef short bf16x8 __attribute__((ext_vector_type(8)));
typedef float f32x4 __attribute__((ext_vector_type(4)));
typedef unsigned u32x4 __attribute__((ext_vector_type(4)));
constexpr int BM = 256, BK = 64, HALF = 128, HTB = HALF * BK * 2  , STAGE_BYTES = 8 * HTB, NXCD = 8, WGM = 8;

__host__ __device__ __forceinline__ int lds_byte(int r, int c) { const int st = (r >> 4) * 2 + (c >> 5), rr = r & 15, cc = c & 31, ob = rr * 64 + cc * 2; return st * 1024 + (ob ^ (((ob >> 9) & 1) << 5)); }
__host__ __device__ __forceinline__ void stage_rc(int b, int& R, int& C) { const int st = b / 1024, sb = b % 1024, swz = sb ^ (((sb >> 9) & 1) << 5); R = (st >> 1) * 16 + swz / 64; C = (st & 1) * 32 + (swz % 64) / 2; }
__host__ __device__ __forceinline__ int perm32(int rho) { const int n = rho >> 4, i = rho & 15; return 8 * (i >> 2) + 4 * n + (i & 3); }

struct Unit { int pm, pn; };
struct Gemm { const bf16_t* A; const bf16_t* Bt; int M, N, K; };

struct StaticOrder {
    int nM, nN, nwg, G, c;
    __host__ __device__ void init(int M, int N, int G_, int c_) { nM = M / BM; nN = N / BM; nwg = nM * nN; G = G_; c = c_; }
    __host__ __device__ bool next(int i, Unit& u) const {
        const long L = (long)i * G + c; if (L >= nwg) return false;
        int wgid = (int)L; { const int q = nwg / NXCD, r = nwg % NXCD, xcd = wgid % NXCD, off = wgid / NXCD; wgid = (xcd < r ? xcd * (q + 1) : r * (q + 1) + (xcd - r) * q) + off; }
        const int nig = WGM * nN, gid = wgid / nig, fm = gid * WGM, gsz = (nM - fm) < WGM ? (nM - fm) : WGM;
        u.pm = fm + ((wgid % nig) % gsz); u.pn = (wgid % nig) / gsz; return true;
    }
    __device__ __forceinline__ void a_ready(const Unit&) const {}
    __device__ __forceinline__ void done(const Unit&) const {}
};
__device__ __forceinline__ unsigned cvt_pk_bf16(float lo, float hi) { unsigned r; asm volatile("v_cvt_pk_bf16_f32 %0, %1, %2" : "=v"(r) : "v"(lo), "v"(hi)); return r; }
typedef float f32x2 __attribute__((ext_vector_type(2)));
template <class Epi, class Sched, bool ALIGN_EPI = false, bool SP2 = false>
__device__ __forceinline__ void gemm_phase(PG8_LAS unsigned char* lds, const Gemm g, const Sched& S, const Epi& E) {
    const int tid = threadIdx.x, wid = __builtin_amdgcn_readfirstlane(tid >> 6), lane = tid & 63, wr = wid >> 2, wc = wid & 3, fr = lane & 15, fq = lane >> 4;
    const int K = g.K, nt = K / BK;
    unsigned voffA[2], voffB[2];
#pragma unroll
    for (int i = 0; i < 2; ++i) { int R, C; stage_rc(tid * 16 + i * 8192, R, C); const int Rb = Epi::PERM ? ((R & ~31) + perm32(R & 31)) : R;
        voffA[i] = (unsigned)(R * K + C) * 2u; voffB[i] = (unsigned)(Rb * K + C) * 2u; }
    const size_t kstep = (size_t)(BK * 2);
    const size_t hstep = (size_t)HALF * K * 2;
    const size_t tstep = 2 * hstep;
    const unsigned ldsw = (unsigned)wid * 1024u;
    const int aoff = lds_byte(wr * 64 + fr, fq * 8), boff = lds_byte(wc * 32 + fr, fq * 8);
#define PG8_SA(b, h) (((b) * 2 + (h)) * HTB)
#define PG8_SB(b, h) ((4 + (b) * 2 + (h)) * HTB)
#define PG8_STAGE(bufoff, gbase, voff) do { _Pragma("unroll") for (int _i = 0; _i < 2; ++_i) \
        __builtin_amdgcn_global_load_lds((const unsigned*)((const char*)(gbase) + (voff)[_i]), (PG8_LAS unsigned*)(lds + (bufoff) + ldsw + _i * 8192), 16, 0, 0); } while (0)
#define PG8_LDA(dst, b, h) do { _Pragma("unroll") for (int m = 0; m < 4; ++m) _Pragma("unroll") for (int k = 0; k < 2; ++k) dst[m][k] = *(const PG8_LAS bf16x8*)(lds + PG8_SA(b, h) + aoff + m * 2048 + k * 1024); } while (0)
#define PG8_LDB(dst, b, h) do { _Pragma("unroll") for (int n = 0; n < 2; ++n) _Pragma("unroll") for (int k = 0; k < 2; ++k) dst[n][k] = *(const PG8_LAS bf16x8*)(lds + PG8_SB(b, h) + boff + n * 2048 + k * 1024); } while (0)
#define PG8_MMA(ai, bj, At, Bt) do { __builtin_amdgcn_s_setprio(1); _Pragma("unroll") for (int m = 0; m < 4; ++m) _Pragma("unroll") for (int n = 0; n < 2; ++n) _Pragma("unroll") for (int k = 0; k < 2; ++k) \
        acc[ai][bj][m][n] = __builtin_amdgcn_mfma_f32_16x16x32_bf16(Bt[n][k], At[m][k], acc[ai][bj][m][n], 0, 0, 0); __builtin_amdgcn_s_setprio(0); } while (0)
#define PG8_WAIT_V(n) asm volatile("s_waitcnt vmcnt(" #n ")" ::: "memory")
#define PG8_WAIT_L(n) asm volatile("s_waitcnt lgkmcnt(" #n ")" ::: "memory")
#define PG8_BAR __builtin_amdgcn_s_barrier()
#define PG8_SCHED __builtin_amdgcn_sched_barrier(0)
    Unit cur, nxt; int ui = 0;
    if (!S.next(0, cur)) return;
    f32x4 acc[2][2][4][2];
#pragma unroll
    for (int a = 0; a < 2; ++a)
#pragma unroll
        for (int b = 0; b < 2; ++b)
#pragma unroll
            for (int m = 0; m < 4; ++m)
#pragma unroll
                for (int n = 0; n < 2; ++n) acc[a][b][m][n] = (f32x4){0.f, 0.f, 0.f, 0.f};
    bf16x8 At[4][2], B0[2][2], B1[2][2];
    const char* cA = (const char*)g.A + (size_t)cur.pm * tstep; const char* cB = (const char*)g.Bt + (size_t)cur.pn * tstep;
    S.a_ready(cur);
    if constexpr (SP2) {
        PG8_STAGE(PG8_SB(0, 0), cB, voffB); PG8_STAGE(PG8_SB(0, 1), cB + hstep, voffB); PG8_STAGE(PG8_SA(0, 0), cA, voffA); PG8_STAGE(PG8_SA(0, 1), cA + hstep, voffA);
        if (wr == 1) PG8_BAR;
        PG8_WAIT_V(2); PG8_BAR;
        PG8_STAGE(PG8_SB(1, 0), cB + kstep, voffB); PG8_STAGE(PG8_SA(1, 0), cA + kstep, voffA); PG8_STAGE(PG8_SB(1, 1), cB + hstep + kstep, voffB);
        PG8_WAIT_V(6); PG8_BAR;
    } else {
        PG8_STAGE(PG8_SB(0, 0), cB, voffB); PG8_STAGE(PG8_SA(0, 0), cA, voffA); PG8_STAGE(PG8_SB(0, 1), cB + hstep, voffB); PG8_STAGE(PG8_SA(0, 1), cA + hstep, voffA);
        if (wr == 1) PG8_BAR;
        PG8_WAIT_V(4); PG8_BAR;
        PG8_STAGE(PG8_SB(1, 0), cB + kstep, voffB); PG8_STAGE(PG8_SA(1, 0), cA + kstep, voffA); PG8_STAGE(PG8_SB(1, 1), cB + hstep + kstep, voffB);
        PG8_WAIT_V(6); PG8_BAR;
    }
    for (;;) {
        const bool has_next = S.next(ui + 1, nxt);
        const char* nA = has_next ? (const char*)g.A + (size_t)nxt.pm * tstep : cA; const char* nB = has_next ? (const char*)g.Bt + (size_t)nxt.pn * tstep : cB;
        for (int t = 0; t < nt; t += 2) {
            const bool last = (t == nt - 2);
            const char* a1 = cA + (size_t)(t + 1) * kstep;
            const char* a2 = last ? nA : cA + (size_t)(t + 2) * kstep; const char* b2 = last ? nB : cB + (size_t)(t + 2) * kstep;
            const char* a3 = a2 + kstep; const char* b3 = b2 + kstep;
            if (last && has_next) S.a_ready(nxt);
            if constexpr (SP2) {
            PG8_LDB(B0, 0, 0); PG8_LDB(B1, 0, 1); PG8_SCHED; PG8_LDA(At, 0, 0); PG8_STAGE(PG8_SA(1, 1), a1 + hstep, voffA);
            PG8_WAIT_V(8); PG8_WAIT_L(0); PG8_BAR; PG8_MMA(0, 0, At, B0); PG8_MMA(0, 1, At, B1); PG8_BAR; PG8_SCHED;
            PG8_LDA(At, 0, 1); PG8_STAGE(PG8_SB(0, 0), b2, voffB); PG8_STAGE(PG8_SB(0, 1), b2 + hstep, voffB); PG8_STAGE(PG8_SA(0, 0), a2, voffA);
            PG8_WAIT_V(8); PG8_WAIT_L(0); PG8_BAR; PG8_MMA(1, 0, At, B0); PG8_MMA(1, 1, At, B1); PG8_BAR; PG8_SCHED;
            PG8_LDB(B0, 1, 0); PG8_LDB(B1, 1, 1); PG8_SCHED; PG8_LDA(At, 1, 0); PG8_STAGE(PG8_SA(0, 1), a2 + hstep, voffA);
            PG8_WAIT_V(8); PG8_WAIT_L(0); PG8_BAR; PG8_MMA(0, 0, At, B0); PG8_MMA(0, 1, At, B1); PG8_BAR; PG8_SCHED;
            PG8_LDA(At, 1, 1); PG8_STAGE(PG8_SB(1, 0), b3, voffB); PG8_STAGE(PG8_SB(1, 1), b3 + hstep, voffB); PG8_STAGE(PG8_SA(1, 0), a3, voffA);
            PG8_WAIT_V(8); PG8_WAIT_L(0); PG8_BAR; PG8_MMA(1, 0, At, B0); PG8_MMA(1, 1, At, B1); PG8_BAR; PG8_SCHED;
            } else {
            PG8_LDB(B0, 0, 0); PG8_SCHED; PG8_LDA(At, 0, 0); PG8_STAGE(PG8_SA(1, 1), a1 + hstep, voffA);
            PG8_WAIT_L(8); PG8_BAR; PG8_WAIT_L(0); PG8_MMA(0, 0, At, B0); PG8_BAR; PG8_SCHED;
            PG8_LDB(B1, 0, 1); PG8_STAGE(PG8_SB(0, 0), b2, voffB);
            PG8_BAR; PG8_WAIT_L(0); PG8_MMA(0, 1, At, B1); PG8_BAR;
            PG8_LDA(At, 0, 1); PG8_STAGE(PG8_SA(0, 0), a2, voffA);
            PG8_BAR; PG8_WAIT_L(0); PG8_MMA(1, 0, At, B0); PG8_BAR; PG8_SCHED;
            PG8_STAGE(PG8_SB(0, 1), b2 + hstep, voffB);
            PG8_WAIT_V(6); PG8_BAR; PG8_MMA(1, 1, At, B1); PG8_BAR;
            PG8_LDB(B0, 1, 0); PG8_SCHED; PG8_LDA(At, 1, 0); PG8_STAGE(PG8_SA(0, 1), a2 + hstep, voffA);
            PG8_WAIT_L(8); PG8_BAR; PG8_WAIT_L(0); PG8_MMA(0, 0, At, B0); PG8_BAR; PG8_SCHED;
            PG8_LDB(B1, 1, 1); PG8_STAGE(PG8_SB(1, 0), b3, voffB);
            PG8_BAR; PG8_WAIT_L(0); PG8_MMA(0, 1, At, B1); PG8_BAR;
            PG8_LDA(At, 1, 1); PG8_STAGE(PG8_SA(1, 0), a3, voffA);
            PG8_BAR; PG8_WAIT_L(0); PG8_MMA(1, 0, At, B0); PG8_BAR; PG8_SCHED;
            PG8_STAGE(PG8_SB(1, 1), b3 + hstep, voffB);
            PG8_WAIT_V(6); PG8_BAR; PG8_MMA(1, 1, At, B1); PG8_BAR;
            }
        }
        if constexpr (ALIGN_EPI) { if (wr == 0) PG8_BAR; }
        if constexpr (!Epi::AFTER_DRAIN) { E(acc, cur, wr, wc, fr, fq); S.done(cur); }
        if (!has_next) break;
#pragma unroll
        for (int a = 0; a < 2; ++a)
#pragma unroll
            for (int b = 0; b < 2; ++b)
#pragma unroll
                for (int m = 0; m < 4; ++m)
#pragma unroll
                    for (int n = 0; n < 2; ++n) acc[a][b][m][n] = (f32x4){0.f, 0.f, 0.f, 0.f};
        cur = nxt; cA = nA; cB = nB; ++ui;
        if constexpr (ALIGN_EPI) { if (wr == 1) PG8_BAR; }
    }
    PG8_WAIT_V(0);
    if constexpr (!ALIGN_EPI) { if (wr == 0) PG8_BAR; }
    PG8_BAR;
    if constexpr (Epi::AFTER_DRAIN) { E.fused(acc, cur, wr, wc, fr, fq, lds, wid, lane); S.done(cur); }
#undef PG8_SA
#undef PG8_SB
#undef PG8_STAGE
#undef PG8_LDA
#undef PG8_LDB
#undef PG8_MMA
#undef PG8_WAIT_V
#undef PG8_WAIT_L
#undef PG8_BAR
#undef PG8_SCHED
}
}

#define PG8_SP2 true
#define PG8_ALIGN true
using pg8::bf16_t; using pg8::f32x4; using pg8::u32x4;
typedef unsigned u32x2 __attribute__((ext_vector_type(2)));

__device__ __forceinline__ float wave_sum(float v) {
#pragma unroll
    for (int o = 1; o < 64; o <<= 1) v += __shfl_xor(v, o);
    return v;
}
__device__ __forceinline__ float wave_max(float v) {
#pragma unroll
    for (int o = 1; o < 64; o <<= 1) v = fmaxf(v, __shfl_xor(v, o));
    return v;
}
__device__ __forceinline__ float silu_fast(float x) { return x * __builtin_amdgcn_rcpf(1.f + __builtin_amdgcn_exp2f(-1.4426950408889634f * x)); }
__device__ __forceinline__ float logsig_f(float x) { return fminf(x, 0.f) - log1pf(expf(-fabsf(x))); }
__device__ __forceinline__ void rope_cs(int pos, int i, float& c, float& s) {
    const float inv = exp2f(-(float)i * (13.287712379549449f / 32.f));
    double a = (double)pos * (double)inv;
    a -= 6.283185307179586 * floor(a * 0.15915494309189535);
    const float r = (float)a;
    c = cosf(r); s = sinf(r);
}
struct Rows2 { const float* a; const float* b; int split; int ld;
    __device__ __forceinline__ const float* row(int r) const { return r < split ? a + (size_t)r * ld : b + (size_t)(r - split) * ld; } };

__device__ __forceinline__ void rms_rows_1024(const Rows2 src, const float* w, float* dst, int nrows) {
    const int lane = threadIdx.x & 63, gw = blockIdx.x * (NTHR / 64) + (threadIdx.x >> 6), ngw = gridDim.x * (NTHR / 64);
    for (int r = gw; r < nrows; r += ngw) {
        const float4* p = (const float4*)src.row(r) + lane;
        float4 v[4]; float s = 0.f;
#pragma unroll
        for (int j = 0; j < 4; ++j) { v[j] = p[64 * j]; s += v[j].x * v[j].x + v[j].y * v[j].y + v[j].z * v[j].z + v[j].w * v[j].w; }
        const float rstd = 1.0f / sqrtf(wave_sum(s) * (1.f / 1024.f) + EPS);
        float4* o = (float4*)(dst + (size_t)r * DM) + lane;
#pragma unroll
        for (int j = 0; j < 4; ++j) { const float4 ww = ((const float4*)w)[lane + 64 * j]; float4 y; y.x = v[j].x * rstd * ww.x; y.y = v[j].y * rstd * ww.y; y.z = v[j].z * rstd * ww.z; y.w = v[j].w * rstd * ww.w; o[64 * j] = y; }
    }
}

constexpr int RSTAB_OFF = 131072 + 6144;
struct RsTab { int p0, p1, p2, p3; const LAS float* tab; };
__device__ __forceinline__ float rstd_from(const float* ssq, int nslot, int row);
__device__ __forceinline__ float rstab_get(const RsTab& T, const float* slots, int pm, int rit) {
    const int s = pm == T.p0 ? 0 : (pm == T.p1 ? 1 : (pm == T.p2 ? 2 : (pm == T.p3 ? 3 : -1)));
    return s >= 0 ? T.tab[s * 256 + rit] : rstd_from(slots, 16, pm * 256 + rit);
}
__device__ __forceinline__ float rstd_from(const float* ssq, int nslot, int row) {
    float s;
    if (nslot == 1) s = ssq[row];
    else { const f32x4* p = (const f32x4*)(ssq + (size_t)row * 16); const f32x4 a = p[0], b = p[1], c = p[2], d = p[3];
        s = (((a[0] + a[1]) + (a[2] + a[3])) + ((b[0] + b[1]) + (b[2] + b[3]))) + (((c[0] + c[1]) + (c[2] + c[3])) + ((d[0] + d[1]) + (d[2] + d[3]))); }
    return 1.0f / sqrtf(s * (1.f / 1024.f) + EPS);
}
template <bool HAS_RS> struct EpiSwigluB { static constexpr bool PERM = true, AFTER_DRAIN = false;
    bf16_t* H; const float* ssq; int nslot; RsTab T;
    __device__ __forceinline__ void operator()(const f32x4 (&acc)[2][2][4][2], const pg8::Unit& u, int wr, int wc, int fr, int fq) const {
        const int row0 = u.pm * 256 + wr * 64 + fr, col0 = u.pn * 128 + wc * 32 + 8 * fq;
#pragma unroll
        for (int ai = 0; ai < 2; ++ai)
#pragma unroll
            for (int m = 0; m < 4; ++m) { const int row = row0 + ai * 128 + m * 16; const float rs = HAS_RS ? rstab_get(T, ssq, u.pm, wr * 64 + fr + ai * 128 + m * 16) : 1.0f;
                const f32x4 g0 = acc[ai][0][m][0] * rs, g1 = acc[ai][0][m][1] * rs, u0 = acc[ai][1][m][0] * rs, u1 = acc[ai][1][m][1] * rs;
                u32x4 w;
                w.x = pg8::cvt_pk_bf16(silu_fast(g0[0]) * u0[0], silu_fast(g0[1]) * u0[1]); w.y = pg8::cvt_pk_bf16(silu_fast(g0[2]) * u0[2], silu_fast(g0[3]) * u0[3]);
                w.z = pg8::cvt_pk_bf16(silu_fast(g1[0]) * u1[0], silu_fast(g1[1]) * u1[1]); w.w = pg8::cvt_pk_bf16(silu_fast(g1[2]) * u1[2], silu_fast(g1[3]) * u1[3]);
                *(u32x4*)(H + (size_t)row * DFF + col0) = w; }
    }
};
template <bool BASE_BF16> struct EpiResidB { static constexpr bool PERM = true, AFTER_DRAIN = false;
    const float* basef; const bf16_t* baseb; bf16_t* outb; float* slots; float scale;
    __device__ __forceinline__ void operator()(const f32x4 (&acc)[2][2][4][2], const pg8::Unit& u, int wr, int wc, int fr, int fq) const {
        const int row0 = u.pm * 256 + wr * 64 + fr, col0 = u.pn * 256 + wc * 32 + 8 * fq;
#pragma unroll
        for (int ai = 0; ai < 2; ++ai) {
            f32x4 pf[4][2][2]; u32x4 pb[4][2];
#pragma unroll
            for (int m = 0; m < 4; ++m) { const size_t ro = (size_t)(row0 + ai * 128 + m * 16) * DM + col0;
#pragma unroll
                for (int bj = 0; bj < 2; ++bj) { if (BASE_BF16) pb[m][bj] = *(const u32x4*)(baseb + ro + bj * 128); else { pf[m][bj][0] = *(const f32x4*)(basef + ro + bj * 128); pf[m][bj][1] = *(const f32x4*)(basef + ro + bj * 128 + 4); } } }
            __builtin_amdgcn_sched_barrier(0);
#pragma unroll
            for (int m = 0; m < 4; ++m) { const int row = row0 + ai * 128 + m * 16; bf16_t* ob = outb + (size_t)row * DM + col0;
                float ss = 0.f;
#pragma unroll
                for (int bj = 0; bj < 2; ++bj) { f32x4 b0, b1;
                    if (BASE_BF16) { const u32x4 r = pb[m][bj];
                        b0 = (f32x4){__uint_as_float(r.x << 16), __uint_as_float(r.x & 0xffff0000u), __uint_as_float(r.y << 16), __uint_as_float(r.y & 0xffff0000u)};
                        b1 = (f32x4){__uint_as_float(r.z << 16), __uint_as_float(r.z & 0xffff0000u), __uint_as_float(r.w << 16), __uint_as_float(r.w & 0xffff0000u)}; }
                    else { b0 = pf[m][bj][0]; b1 = pf[m][bj][1]; }
                    const f32x4 o0 = b0 + acc[ai][bj][m][0] * scale, o1 = b1 + acc[ai][bj][m][1] * scale;
                    ss += ((o0[0] * o0[0] + o0[1] * o0[1]) + (o0[2] * o0[2] + o0[3] * o0[3])) + ((o1[0] * o1[0] + o1[1] * o1[1]) + (o1[2] * o1[2] + o1[3] * o1[3]));
                    u32x4 w; w.x = pg8::cvt_pk_bf16(o0[0], o0[1]); w.y = pg8::cvt_pk_bf16(o0[2], o0[3]); w.z = pg8::cvt_pk_bf16(o1[0], o1[1]); w.w = pg8::cvt_pk_bf16(o1[2], o1[3]);
                    *(u32x4*)(ob + bj * 128) = w; }
                ss += __shfl_xor(ss, 16); ss += __shfl_xor(ss, 32);
                if (fq == 0) slots[(size_t)row * 16 + u.pn * 4 + wc] = ss; } }
    }
};
struct EpiProj2 { static constexpr bool PERM = false, AFTER_DRAIN = false;
    float* PROJ; const float* slots; RsTab T; bf16_t* CQB; float* CQS; float* CKV; float* KPR; bf16_t* QG; bf16_t* KG; bf16_t* VT; float* VS; bf16_t* SG; float* ALOW;
    __device__ __forceinline__ void operator()(const f32x4 (&acc)[2][2][4][2], const pg8::Unit& u, int wr, int wc, int fr, int fq) const {
        const int row0 = u.pm * 256 + wr * 64 + fr, col0 = u.pn * 256 + wc * 32 + 4 * fq;
#pragma unroll
        for (int ai = 0; ai < 2; ++ai) { if (u.pm == PAD_PM && ai == 1) continue;
#pragma unroll
            for (int m = 0; m < 4; ++m) { const int row = row0 + ai * 128 + m * 16; const float rs = rstab_get(T, slots, u.pm, wr * 64 + fr + ai * 128 + m * 16);
                float ss = 0.f;
#pragma unroll
                for (int bj = 0; bj < 2; ++bj)
#pragma unroll
                    for (int n = 0; n < 2; ++n) { const int c = col0 + bj * 128 + n * 16; const f32x4 v = acc[ai][bj][m][n] * rs;
                        if (u.pn == 0) { u32x2 w; w.x = pg8::cvt_pk_bf16(v[0] * 0.125f, v[1] * 0.125f); w.y = pg8::cvt_pk_bf16(v[2] * 0.125f, v[3] * 0.125f); *(u32x2*)(QG + (size_t)row * 256 + c) = w; }
                        if (u.pn == 1) { u32x2 w; w.x = pg8::cvt_pk_bf16(v[0], v[1]); w.y = pg8::cvt_pk_bf16(v[2], v[3]); *(u32x2*)(KG + (size_t)row * 256 + (c - 256)) = w; }
                        if (u.pn == 4 || u.pn == 5) { u32x2 w; w.x = pg8::cvt_pk_bf16(silu_fast(v[0]), silu_fast(v[1])); w.y = pg8::cvt_pk_bf16(silu_fast(v[2]), silu_fast(v[3])); *(u32x2*)(SG + (size_t)row * 512 + (c - 1024)) = w; }
                        if (u.pn == 6) { u32x2 w; w.x = pg8::cvt_pk_bf16(v[0], v[1]); w.y = pg8::cvt_pk_bf16(v[2], v[3]); *(u32x2*)(CQB + (size_t)row * 256 + (c - 1536)) = w;
                            ss += (v[0] * v[0] + v[1] * v[1]) + (v[2] * v[2] + v[3] * v[3]); }
                        if (u.pn == 7) { const int cc = c - 1792;
                            if (cc < 128) *(f32x4*)(CKV + (size_t)row * 128 + cc) = v;
                            else if (cc < 192) *(f32x4*)(KPR + (size_t)row * 64 + (cc - 128)) = v;
                            else if (cc < 208) *(f32x4*)(ALOW + (size_t)row * 16 + (cc - 192)) = v; } }
                if (u.pn == 6) { ss += __shfl_xor(ss, 16); ss += __shfl_xor(ss, 32); if (fq == 0) CQS[(size_t)row * 4 + wc] = ss; } } }
    }
};
constexpr float QSCALE = 0.07216878364870322f * 1.4426950408889634f;
struct EpiQabs { static constexpr bool PERM = true, AFTER_DRAIN = false;
    bf16_t* QA; const float* CQS; const float2* RT;
    __device__ __forceinline__ void operator()(const f32x4 (&acc)[2][2][4][2], const pg8::Unit& u, int wr, int wc, int fr, int fq) const {
        const int row0 = u.pm * 256 + wr * 64 + fr, colt = wc * 32 + 8 * fq;
#pragma unroll
        for (int ai = 0; ai < 2; ++ai) { if (u.pm == PAD_PM && ai == 1) continue;
#pragma unroll
            for (int m = 0; m < 4; ++m) { const int row = row0 + ai * 128 + m * 16; const f32x4 sl = *(const f32x4*)(CQS + (size_t)row * 4);
                const float rq = QSCALE / sqrtf(((sl[0] + sl[1]) + (sl[2] + sl[3])) * (1.f / 256.f) + EPS);
#pragma unroll
                for (int bj = 0; bj < 2; ++bj) { const f32x4 v0 = acc[ai][bj][m][0] * rq, v1 = acc[ai][bj][m][1] * rq; const int cc = bj * 128 + colt;
                    u32x4 w; w.x = pg8::cvt_pk_bf16(v0[0], v0[1]); w.y = pg8::cvt_pk_bf16(v0[2], v0[3]); w.z = pg8::cvt_pk_bf16(v1[0], v1[1]); w.w = pg8::cvt_pk_bf16(v1[2], v1[3]);
                    *(u32x4*)(QA + (size_t)row * 768 + u.pn * 256 + cc) = w; } } }
    }
};

typedef short bf16x8 __attribute__((ext_vector_type(8)));
typedef float f32x16 __attribute__((ext_vector_type(16)));
typedef short s16x4 __attribute__((ext_vector_type(4)));
typedef float f32x2_t __attribute__((ext_vector_type(2))); typedef __bf16 bf16x2_t __attribute__((ext_vector_type(2)));
__device__ __forceinline__ unsigned cvtpk_s(float lo, float hi) { f32x2_t v = {lo, hi}; bf16x2_t b = __builtin_convertvector(v, bf16x2_t); return __builtin_bit_cast(unsigned, b); }
__device__ __forceinline__ s16x4 vtr(const LAS unsigned char* p) { return __builtin_bit_cast(s16x4, __builtin_amdgcn_ds_read_tr16_b64_v4i16((LAS s16x4*)p)); }
__device__ __forceinline__ int crow(int r, int hi) { return (r & 3) + 8 * (r >> 2) + 4 * hi; }
constexpr int AT_ROWB = 400, AT_BUF = 64 * AT_ROWB;
__device__ __forceinline__ void mla_attn_unit(LAS unsigned char* ldsl, const bf16_t* QA, const bf16_t* KL, const float2* RT, bf16_t* YMIXB, int b, int qb, int tid, int lane, int wave) {
    const int hh = wave >> 1, qs = wave & 1, r32 = lane & 31, hi = lane >> 5;
    const int qpos = qb * 64 + qs * 32 + r32; const size_t qrow = (size_t)b * SEQ + qpos;
    bf16x8 qf[12];
#pragma unroll
    for (int ks = 0; ks < 8; ++ks) qf[ks] = *(const bf16x8*)(QA + qrow * 768 + hh * 128 + 16 * ks + 8 * hi);
#pragma unroll
    for (int ks = 0; ks < 4; ++ks) {
        const u32x4 raw = *(const u32x4*)(QA + qrow * 768 + 512 + hh * 64 + 16 * ks + 8 * hi);
        const f32x4* rp = (const f32x4*)(RT + (size_t)qpos * 32 + 8 * ks + 4 * hi); const f32x4 t0 = rp[0], t1 = rp[1];
        u32x4 w;
        { const float x1 = __uint_as_float(raw.x << 16), x2 = __uint_as_float(raw.x & 0xffff0000u); w.x = cvtpk_s(x1 * t0[0] - x2 * t0[1], x1 * t0[1] + x2 * t0[0]); }
        { const float x1 = __uint_as_float(raw.y << 16), x2 = __uint_as_float(raw.y & 0xffff0000u); w.y = cvtpk_s(x1 * t0[2] - x2 * t0[3], x1 * t0[3] + x2 * t0[2]); }
        { const float x1 = __uint_as_float(raw.z << 16), x2 = __uint_as_float(raw.z & 0xffff0000u); w.z = cvtpk_s(x1 * t1[0] - x2 * t1[1], x1 * t1[1] + x2 * t1[0]); }
        { const float x1 = __uint_as_float(raw.w << 16), x2 = __uint_as_float(raw.w & 0xffff0000u); w.w = cvtpk_s(x1 * t1[2] - x2 * t1[3], x1 * t1[3] + x2 * t1[2]); }
        qf[8 + ks] = __builtin_bit_cast(bf16x8, w); }
    f32x16 o[4];
#pragma unroll
    for (int d = 0; d < 4; ++d)
#pragma unroll
        for (int r = 0; r < 16; ++r) o[d][r] = 0.f;
    float mrun = -1e30f, lrun = 0.f;
    const int nt = qb + 1;
    const unsigned char* kg = (const unsigned char*)(KL + (size_t)b * SEQ * 192);
    u32x4 stg[3];
#pragma unroll
    for (int i = 0; i < 3; ++i) stg[i] = *(const u32x4*)(kg + (size_t)(tid + 512 * i) * 16);
#pragma unroll
    for (int i = 0; i < 3; ++i) { const int c = tid + 512 * i, row = c / 24, col = c - row * 24; *(LAS u32x4*)(ldsl + row * AT_ROWB + col * 16) = stg[i]; }
    __syncthreads();
    const int blk = (lane >> 4) & 1, q4 = (lane & 15) >> 2, p4 = lane & 3;
    const bool gB = wave >= 4;
#define AT_LOADT(tt) _Pragma("unroll") for (int i = 0; i < 3; ++i) stg[i] = *(const u32x4*)(kg + (size_t)(tt) * 24576 + (size_t)(tid + 512 * i) * 16);
#define AT_WRITET(tt) _Pragma("unroll") for (int i = 0; i < 3; ++i) { const int c = tid + 512 * i, row = c / 24, col = c - row * 24; *(LAS u32x4*)(ldsl + ((tt) & 1) * AT_BUF + row * AT_ROWB + col * 16) = stg[i]; }
    if (gB) { if (nt > 1) { AT_LOADT(1) } __syncthreads(); }
    for (int t = 0; t < nt; ++t) {
        const LAS unsigned char* kb = ldsl + (t & 1) * AT_BUF;
        if (!gB && t + 1 < nt) { AT_LOADT(t + 1) }
        f32x16 s0, s1;
#pragma unroll
        for (int r = 0; r < 16; ++r) { s0[r] = 0.f; s1[r] = 0.f; }
#pragma unroll
        for (int ks = 0; ks < 12; ++ks) {
            const bf16x8 k0 = *(const LAS bf16x8*)(kb + r32 * AT_ROWB + 32 * ks + 16 * hi);
            const bf16x8 k1 = *(const LAS bf16x8*)(kb + (32 + r32) * AT_ROWB + 32 * ks + 16 * hi);
            s0 = __builtin_amdgcn_mfma_f32_32x32x16_bf16(k0, qf[ks], s0, 0, 0, 0);
            s1 = __builtin_amdgcn_mfma_f32_32x32x16_bf16(k1, qf[ks], s1, 0, 0, 0);
        }
        if (gB && t + 1 < nt) { AT_WRITET(t + 1) }
        __syncthreads();
        if (gB && t + 2 < nt) { AT_LOADT(t + 2) }
        if (t == qb) {
#pragma unroll
            for (int r = 0; r < 16; ++r) { const int kv = t * 64 + crow(r, hi); if (kv > qpos) s0[r] = -INFINITY; if (kv + 32 > qpos) s1[r] = -INFINITY; }
        }
        float mx = fmaxf(s0[0], s1[0]);
#pragma unroll
        for (int r = 1; r < 16; ++r) mx = fmaxf(mx, fmaxf(s0[r], s1[r]));
        mx = fmaxf(mx, __shfl_xor(mx, 32));
        const float mn = fmaxf(mrun, mx), alpha = __builtin_amdgcn_exp2f(mrun - mn);
        float ps = 0.f;
#pragma unroll
        for (int r = 0; r < 16; ++r) { s0[r] = __builtin_amdgcn_exp2f(s0[r] - mn); s1[r] = __builtin_amdgcn_exp2f(s1[r] - mn); ps += s0[r] + s1[r]; }
        lrun = lrun * alpha + ps; mrun = mn;
        if (__any(alpha != 1.0f)) {
#pragma unroll
            for (int d = 0; d < 4; ++d)
#pragma unroll
                for (int r = 0; r < 16; ++r) o[d][r] *= alpha; }
        bf16x8 pf[4];
#pragma unroll
        for (int s = 0; s < 2; ++s) {
            u32x4 w0, w1;
            w0.x = cvtpk_s(s0[8 * s + 0], s0[8 * s + 1]); w0.y = cvtpk_s(s0[8 * s + 2], s0[8 * s + 3]); w0.z = cvtpk_s(s0[8 * s + 4], s0[8 * s + 5]); w0.w = cvtpk_s(s0[8 * s + 6], s0[8 * s + 7]);
            w1.x = cvtpk_s(s1[8 * s + 0], s1[8 * s + 1]); w1.y = cvtpk_s(s1[8 * s + 2], s1[8 * s + 3]); w1.z = cvtpk_s(s1[8 * s + 4], s1[8 * s + 5]); w1.w = cvtpk_s(s1[8 * s + 6], s1[8 * s + 7]);
            pf[s] = __builtin_bit_cast(bf16x8, w0); pf[2 + s] = __builtin_bit_cast(bf16x8, w1);
        }
#pragma unroll
        for (int d = 0; d < 4; ++d)
#pragma unroll
            for (int kk = 0; kk < 4; ++kk) {
                const int R = 32 * (kk >> 1) + 16 * (kk & 1) + 4 * hi;
                const LAS unsigned char* vp = kb + (R + q4) * AT_ROWB + (32 * d + 16 * blk) * 2 + 8 * p4;
                const s16x4 lo = vtr(vp), hi4 = vtr(vp + 8 * AT_ROWB);
                const bf16x8 vf = (bf16x8){lo[0], lo[1], lo[2], lo[3], hi4[0], hi4[1], hi4[2], hi4[3]};
                o[d] = __builtin_amdgcn_mfma_f32_32x32x16_bf16(vf, pf[kk], o[d], 0, 0, 0);
            }
        if (!gB && t + 1 < nt) { AT_WRITET(t + 1) }
        __syncthreads();
    }
    if (!gB) __syncthreads();
#undef AT_LOADT
#undef AT_WRITET
    const float il = 1.0f / (lrun + __shfl_xor(lrun, 32));
#pragma unroll
    for (int d = 0; d < 4; ++d)
#pragma unroll
        for (int g4 = 0; g4 < 4; ++g4) { u32x2 w; w.x = cvtpk_s(o[d][4 * g4] * il, o[d][4 * g4 + 1] * il); w.y = cvtpk_s(o[d][4 * g4 + 2] * il, o[d][4 * g4 + 3] * il);
            *(u32x2*)(YMIXB + qrow * DM + 512 + hh * 128 + 32 * d + 8 * g4 + 4 * hi) = w; }
}

__device__ __forceinline__ float bf2f(bf16_t x) { return __uint_as_float((unsigned)x << 16); }
constexpr int KTT_PITCH = 144, KTT_BYTES = 64 * KTT_PITCH;
__device__ __forceinline__ void gla_prep_unit(LAS unsigned char* ktt, bf16_t* QG, bf16_t* KG, const float* ALOW, const float* w_a_up, const float* b_a, const bf16_t* VT, float* DEC, bf16_t* UT, int u, int lane) {
    const int c = u & 31, bh = u >> 5, h = bh & 3, b = bh >> 2;
    const size_t row0 = (size_t)b * SEQ + c * 64;
    const int d = lane;
    float wa[16];
#pragma unroll
    for (int r = 0; r < 16; ++r) wa[r] = w_a_up[r * 256 + h * 64 + d];
    const float ba = b_a[h * 64 + d];
    float bsum = 0.f;
#pragma unroll 8
    for (int t = 0; t < 64; ++t) {
        const size_t row = row0 + t;
        const f32x4* ap = (const f32x4*)(ALOW + row * 16); const f32x4 a0 = ap[0], a1 = ap[1], a2 = ap[2], a3 = ap[3];
        float x = ba;
        x += a0[0] * wa[0]; x += a0[1] * wa[1]; x += a0[2] * wa[2]; x += a0[3] * wa[3]; x += a1[0] * wa[4]; x += a1[1] * wa[5]; x += a1[2] * wa[6]; x += a1[3] * wa[7];
        x += a2[0] * wa[8]; x += a2[1] * wa[9]; x += a2[2] * wa[10]; x += a2[3] * wa[11]; x += a3[0] * wa[12]; x += a3[1] * wa[13]; x += a3[2] * wa[14]; x += a3[3] * wa[15];
        const float l2 = (fminf(x, 0.f) * 1.4426950408889634f - __builtin_amdgcn_logf(1.f + __builtin_amdgcn_exp2f(-fabsf(x) * 1.4426950408889634f))) * (1.f / 16.f);
        bsum += l2;
        const float eb = __builtin_amdgcn_exp2f(bsum), enb = __builtin_amdgcn_exp2f(-bsum);
        const size_t off = row * 256 + h * 64 + d;
        const float q = bf2f(QG[off]), k = bf2f(KG[off]);
        const unsigned pk = pg8::cvt_pk_bf16(q * eb, k * enb);
        QG[off] = (bf16_t)(pk & 0xffffu); KG[off] = (bf16_t)(pk >> 16);
        *(LAS bf16_t*)(ktt + d * KTT_PITCH + t * 2) = (bf16_t)(pk >> 16);
    }
    DEC[(size_t)u * 64 + d] = __builtin_amdgcn_exp2f(bsum);
    asm volatile("s_waitcnt lgkmcnt(0)" ::: "memory");
    const int r32 = lane & 31, hi = lane >> 5;
    bf16x8 kf[2][4];
#pragma unroll
    for (int db = 0; db < 2; ++db)
#pragma unroll
        for (int s = 0; s < 4; ++s) kf[db][s] = *(const LAS bf16x8*)(ktt + (32 * db + r32) * KTT_PITCH + (16 * s + 8 * hi) * 2);
    const bf16_t* vt = VT + ((size_t)(bh * 128)) * 2048 + c * 64;
#pragma unroll
    for (int vb = 0; vb < 4; ++vb) {
        bf16x8 vf[4];
#pragma unroll
        for (int s = 0; s < 4; ++s) vf[s] = *(const bf16x8*)(vt + (size_t)(32 * vb + r32) * 2048 + 16 * s + 8 * hi);
#pragma unroll
        for (int db = 0; db < 2; ++db) {
            f32x16 acc;
#pragma unroll
            for (int r = 0; r < 16; ++r) acc[r] = 0.f;
#pragma unroll
            for (int s = 0; s < 4; ++s) acc = __builtin_amdgcn_mfma_f32_32x32x16_bf16(vf[s], kf[db][s], acc, 0, 0, 0);
#pragma unroll
            for (int r = 0; r < 16; ++r) UT[((size_t)u * 128 + 32 * vb + crow(r, hi)) * 64 + 32 * db + r32] = (bf16_t)(cvtpk_s(acc[r], 0.f) & 0xffffu);
        }
    }
    asm volatile("s_waitcnt lgkmcnt(0)" ::: "memory");
}
constexpr int GD_PITCH = 132, GD_BYTES = 32 * GD_PITCH * 4;
__device__ __forceinline__ void gla_out_unit(LAS unsigned char* wl, const bf16_t* QT, const bf16_t* KT, const bf16_t* VT, const bf16_t* ST, const bf16_t* SG, const float* gnw, bf16_t* YMIXB, int u, int lane) {
    const int ib = u & 1, c = (u >> 1) & 31, bh = u >> 6, h = bh & 3, b = bh >> 2;
    const size_t row0 = (size_t)b * SEQ + c * 64;
    const int r32 = lane & 31, hi = lane >> 5;
    const size_t row = row0 + 32 * ib + r32;
    bf16x8 qb[4], sf[4][4], kf[2][4];
#pragma unroll
    for (int s = 0; s < 4; ++s) qb[s] = *(const bf16x8*)(QT + row * 256 + h * 64 + 16 * s + 8 * hi);
    const bf16_t* st = ST + (size_t)(bh * 32 + c) * 128 * 64;
#pragma unroll
    for (int vb = 0; vb < 4; ++vb)
#pragma unroll
        for (int s = 0; s < 4; ++s) sf[vb][s] = *(const bf16x8*)(st + (size_t)(32 * vb + r32) * 64 + 16 * s + 8 * hi);
#pragma unroll
    for (int jb = 0; jb < 2; ++jb)
#pragma unroll
        for (int s = 0; s < 4; ++s) kf[jb][s] = *(const bf16x8*)(KT + (row0 + 32 * (jb <= ib ? jb : 0) + r32) * 256 + h * 64 + 16 * s + 8 * hi);
    __builtin_amdgcn_sched_barrier(0);
    f32x16 o[4];
#pragma unroll
    for (int vb = 0; vb < 4; ++vb) {
#pragma unroll
        for (int r = 0; r < 16; ++r) o[vb][r] = 0.f;
#pragma unroll
        for (int s = 0; s < 4; ++s) o[vb] = __builtin_amdgcn_mfma_f32_32x32x16_bf16(sf[vb][s], qb[s], o[vb], 0, 0, 0); }
    const bf16_t* vt = VT + ((size_t)(bh * 128)) * 2048 + c * 64;
    u32x4 vv[2][2][4];
#pragma unroll
    for (int jb = 0; jb < 2; ++jb)
#pragma unroll
        for (int s2 = 0; s2 < 2; ++s2)
#pragma unroll
            for (int vb = 0; vb < 4; ++vb) { const bf16_t* vp = vt + (size_t)(32 * vb + r32) * 2048 + 32 * (jb <= ib ? jb : 0) + 16 * s2 + 8 * hi;
                const u32x4 raw = *(const u32x4*)vp;
                const auto s0_ = __builtin_amdgcn_permlane32_swap(raw.x, raw.z, false, false); const auto s1_ = __builtin_amdgcn_permlane32_swap(raw.y, raw.w, false, false);
                vv[jb][s2][vb] = (u32x4){s0_[0], s1_[0], s0_[1], s1_[1]}; }
    __builtin_amdgcn_sched_barrier(0);
#pragma unroll
    for (int jb = 0; jb < 2; ++jb) {
        if (jb <= ib) {
            f32x16 x;
#pragma unroll
            for (int r = 0; r < 16; ++r) x[r] = 0.f;
#pragma unroll
            for (int s = 0; s < 4; ++s) x = __builtin_amdgcn_mfma_f32_32x32x16_bf16(kf[jb][s], qb[s], x, 0, 0, 0);
            if (jb == ib) {
#pragma unroll
                for (int r = 0; r < 16; ++r) if (crow(r, hi) > r32) x[r] = 0.f; }
#pragma unroll
            for (int s2 = 0; s2 < 2; ++s2) {
                u32x4 w; w.x = cvtpk_s(x[8 * s2 + 0], x[8 * s2 + 1]); w.y = cvtpk_s(x[8 * s2 + 2], x[8 * s2 + 3]); w.z = cvtpk_s(x[8 * s2 + 4], x[8 * s2 + 5]); w.w = cvtpk_s(x[8 * s2 + 6], x[8 * s2 + 7]);
                const bf16x8 pf = __builtin_bit_cast(bf16x8, w);
#pragma unroll
                for (int vb = 0; vb < 4; ++vb) o[vb] = __builtin_amdgcn_mfma_f32_32x32x16_bf16(__builtin_bit_cast(bf16x8, vv[jb][s2][vb]), pf, o[vb], 0, 0, 0);
            }
        }
    }
    float ss = 0.f;
#pragma unroll
    for (int vb = 0; vb < 4; ++vb)
#pragma unroll
        for (int r = 0; r < 16; ++r) ss += o[vb][r] * o[vb][r];
    ss += __shfl_xor(ss, 32);
    u32x4 sgp[8];
#pragma unroll
    for (int k = 0; k < 8; ++k) { const int p = lane + 64 * k; sgp[k] = *(const u32x4*)(SG + (row0 + 32 * ib + (p >> 4)) * 512 + h * 128 + 8 * (p & 15)); }
    const float rstd = 1.0f / sqrtf(ss * (1.f / 128.f) + EPS);
    LAS float* tl = (LAS float*)wl;
#pragma unroll
    for (int vb = 0; vb < 4; ++vb)
#pragma unroll
        for (int g4 = 0; g4 < 4; ++g4) *(LAS f32x4*)(tl + r32 * GD_PITCH + 32 * vb + 8 * g4 + 4 * hi) = (f32x4){o[vb][4 * g4 + 0] * rstd, o[vb][4 * g4 + 1] * rstd, o[vb][4 * g4 + 2] * rstd, o[vb][4 * g4 + 3] * rstd};
    asm volatile("s_waitcnt lgkmcnt(0)" ::: "memory");
#pragma unroll
    for (int k = 0; k < 8; ++k) { const int p = lane + 64 * k, tok = p >> 4, v8 = 8 * (p & 15);
        const f32x4 a = *(const LAS f32x4*)(tl + tok * GD_PITCH + v8), b2 = *(const LAS f32x4*)(tl + tok * GD_PITCH + v8 + 4);
        const f32x4 g0 = *(const f32x4*)(gnw + v8), g1 = *(const f32x4*)(gnw + v8 + 4); const u32x4 sgv = sgp[k];
        u32x4 w;
        w.x = cvtpk_s(a[0] * g0[0] * __uint_as_float(sgv.x << 16), a[1] * g0[1] * __uint_as_float(sgv.x & 0xffff0000u));
        w.y = cvtpk_s(a[2] * g0[2] * __uint_as_float(sgv.y << 16), a[3] * g0[3] * __uint_as_float(sgv.y & 0xffff0000u));
        w.z = cvtpk_s(b2[0] * g1[0] * __uint_as_float(sgv.z << 16), b2[1] * g1[1] * __uint_as_float(sgv.z & 0xffff0000u));
        w.w = cvtpk_s(b2[2] * g1[2] * __uint_as_float(sgv.w << 16), b2[3] * g1[3] * __uint_as_float(sgv.w & 0xffff0000u));
        *(u32x4*)(YMIXB + (row0 + 32 * ib + tok) * DM + h * 128 + v8) = w; }
    asm volatile("s_waitcnt lgkmcnt(0)" ::: "memory");
}

constexpr int DQ_BYTES = 32 * AT_ROWB;
__device__ __forceinline__ void decode_item_mfma(LAS unsigned char* ldsl, const bf16_t* QA, const float2* RT, const float* cache_kv, const float* cache_pe, const int* page_table, float* PART, int item, int tid, int lane, int wave) {
    const int bs = item >> 1, half = item & 1, r32 = lane & 31, hi = lane >> 5;
    const size_t qrow = (size_t)(MP + bs);
    __syncthreads();
#pragma unroll 1
    for (int e = 100 + tid; e < 32 * AT_ROWB / 16; e += 512) *(LAS u32x4*)(ldsl + e * 16) = (u32x4){0u, 0u, 0u, 0u};
#pragma unroll 1
    for (int e = tid; e < 768; e += 512) { const int row = e >= 576 ? 3 : (e >= 384 ? 2 : (e >= 192 ? 1 : 0)), col = e - 192 * row; float v;
        if (col < 128) v = bf2f(QA[qrow * 768 + row * 128 + col]);
        else { const int n = col - 128, ii = n & 31; const unsigned pr = *(const unsigned*)(QA + qrow * 768 + 512 + row * 64 + 2 * ii);
            const float x1 = __uint_as_float(pr << 16), x2 = __uint_as_float(pr & 0xffff0000u); const float2 cs = RT[(size_t)SEQ * 32 + ii]; v = n < 32 ? x1 * cs.x - x2 * cs.y : x1 * cs.y + x2 * cs.x; }
        *(LAS bf16_t*)(ldsl + row * AT_ROWB + col * 2) = (bf16_t)(cvtpk_s(v, 0.f) & 0xffffu); }
    if (tid < 4) { *(LAS u32x4*)(ldsl + tid * AT_ROWB + 384) = (u32x4){0u, 0u, 0u, 0u}; }
    __syncthreads();
    LAS unsigned char* kt = ldsl + (1 + wave) * DQ_BYTES;
    const int ptv = page_table[bs * NPAGES + half * 32 + r32];
    f32x16 o[4];
#pragma unroll
    for (int d = 0; d < 4; ++d)
#pragma unroll
        for (int r = 0; r < 16; ++r) o[d][r] = 0.f;
    float mrun = -1e30f, lrun = 0.f;
    const int blk = (lane >> 4) & 1, q4 = (lane & 15) >> 2, p4 = lane & 3;
    f32x4 sl[16], sp[8];
    const __amdgpu_buffer_rsrc_t rkv = __builtin_amdgcn_make_buffer_rsrc((void*)cache_kv, 0, 0x7fffffff, 0x00020000);
    const __amdgpu_buffer_rsrc_t rpe = __builtin_amdgcn_make_buffer_rsrc((void*)cache_pe, 0, 0x7fffffff, 0x00020000);
    const int lo16 = lane * 16;
#define DM_LOAD(kbi) { const int j0_ = 32 * (kbi); const int pg_ = __builtin_amdgcn_readlane(ptv, j0_ >> 7); const int r0_ = pg_ * PAGE + (j0_ & 127); \
        _Pragma("unroll") for (int c_ = 0; c_ < 16; ++c_) sl[c_] = __builtin_bit_cast(f32x4, __builtin_amdgcn_raw_buffer_load_b128(rkv, lo16, r0_ * 512 + 1024 * c_, 2)); \
        _Pragma("unroll") for (int c_ = 0; c_ < 8; ++c_) sp[c_] = __builtin_bit_cast(f32x4, __builtin_amdgcn_raw_buffer_load_b128(rpe, lo16, r0_ * 256 + 1024 * c_, 2)); }
    DM_LOAD(wave)
    for (int i = 0; i < 16; ++i) {
#pragma unroll
        for (int c = 0; c < 16; ++c) { const int ch = lane + 64 * c, row = ch >> 5, col4 = ch & 31; u32x2 w; w.x = cvtpk_s(sl[c][0], sl[c][1]); w.y = cvtpk_s(sl[c][2], sl[c][3]); *(LAS u32x2*)(kt + row * AT_ROWB + col4 * 8) = w; }
#pragma unroll
        for (int c = 0; c < 8; ++c) { const int ch = lane + 64 * c, row = ch >> 4, col4 = ch & 15; u32x2 w; w.x = cvtpk_s(sp[c][0], sp[c][1]); w.y = cvtpk_s(sp[c][2], sp[c][3]); *(LAS u32x2*)(kt + row * AT_ROWB + 256 + col4 * 8) = w; }
        { const int in_ = i + 1 < 16 ? i + 1 : 15; DM_LOAD(wave + 8 * in_) }
        f32x16 s;
#pragma unroll
        for (int r = 0; r < 16; ++r) s[r] = 0.f;
#pragma unroll
        for (int ks = 0; ks < 12; ++ks) { const bf16x8 kf = *(const LAS bf16x8*)(kt + r32 * AT_ROWB + 32 * ks + 16 * hi); const bf16x8 qfr = *(const LAS bf16x8*)(ldsl + r32 * AT_ROWB + 32 * ks + 16 * hi);
            s = __builtin_amdgcn_mfma_f32_32x32x16_bf16(kf, qfr, s, 0, 0, 0); }
        float mx = s[0];
#pragma unroll
        for (int r = 1; r < 16; ++r) mx = fmaxf(mx, s[r]);
        mx = fmaxf(mx, __shfl_xor(mx, 32));
        const float mn = fmaxf(mrun, mx), alpha = __builtin_amdgcn_exp2f(mrun - mn);
        float ps = 0.f;
#pragma unroll
        for (int r = 0; r < 16; ++r) { s[r] = __builtin_amdgcn_exp2f(s[r] - mn); ps += s[r]; }
        lrun = lrun * alpha + ps; mrun = mn;
        if (__any(alpha != 1.0f)) {
#pragma unroll
            for (int d = 0; d < 4; ++d)
#pragma unroll
                for (int r = 0; r < 16; ++r) o[d][r] *= alpha; }
        bf16x8 pf[2];
#pragma unroll
        for (int s2 = 0; s2 < 2; ++s2) { u32x4 w; w.x = cvtpk_s(s[8 * s2 + 0], s[8 * s2 + 1]); w.y = cvtpk_s(s[8 * s2 + 2], s[8 * s2 + 3]); w.z = cvtpk_s(s[8 * s2 + 4], s[8 * s2 + 5]); w.w = cvtpk_s(s[8 * s2 + 6], s[8 * s2 + 7]); pf[s2] = __builtin_bit_cast(bf16x8, w); }
#pragma unroll
        for (int d = 0; d < 4; ++d)
#pragma unroll
            for (int s2 = 0; s2 < 2; ++s2) { const int R = 16 * s2 + 4 * hi; const LAS unsigned char* vp = kt + (R + q4) * AT_ROWB + (32 * d + 16 * blk) * 2 + 8 * p4;
                const s16x4 lo = vtr(vp), hi4 = vtr(vp + 8 * AT_ROWB); const bf16x8 vf = (bf16x8){lo[0], lo[1], lo[2], lo[3], hi4[0], hi4[1], hi4[2], hi4[3]};
                o[d] = __builtin_amdgcn_mfma_f32_32x32x16_bf16(vf, pf[s2], o[d], 0, 0, 0); }
    }
#undef DM_LOAD
    const float ltot = lrun + __shfl_xor(lrun, 32);
    asm volatile("s_waitcnt vmcnt(0) lgkmcnt(0)" ::: "memory");
    LAS float* sw = (LAS float*)kt;
    if (r32 < 4) {
#pragma unroll
        for (int d = 0; d < 4; ++d)
#pragma unroll
            for (int r = 0; r < 16; ++r) sw[r32 * 130 + 32 * d + crow(r, hi)] = o[d][r];
        if (hi == 0) { sw[r32 * 130 + 128] = mrun; sw[r32 * 130 + 129] = ltot; } }
    __syncthreads();
    {   const int h = tid >> 7, dim = tid & 127; float M = -1e30f;
#pragma unroll
        for (int w = 0; w < 8; ++w) M = fmaxf(M, ((const LAS float*)(ldsl + (1 + w) * DQ_BYTES))[h * 130 + 128]);
        float L = 0.f, O = 0.f;
#pragma unroll
        for (int w = 0; w < 8; ++w) { const LAS float* pw = (const LAS float*)(ldsl + (1 + w) * DQ_BYTES) + h * 130; const float f = __builtin_amdgcn_exp2f(pw[128] - M); L += pw[129] * f; O += pw[dim] * f; }
        float* pp = PART + (size_t)(item * 4 + h) * 132; pp[dim] = O; if (dim == 0) { pp[128] = M; pp[129] = L; } }
    __syncthreads();
}

template <int NB>
__device__ __forceinline__ void skinny_tile(LAS unsigned char* ldsl, const bf16_t* A, int lda, const bf16_t* B0, const bf16_t* B1, int K, int lane, int wave, f32x4 (&acc)[NB], float& ssq) {
    const int r16 = lane & 15, kq = lane >> 4; int kw = K >> 3; asm volatile("" : "+s"(kw));
    f32x4 pa[NB][8]; float ps[8];
#pragma unroll
    for (int g = 0; g < 8; ++g) { ps[g] = 0.f;
#pragma unroll
        for (int n = 0; n < NB; ++n) pa[n][g] = (f32x4){0.f, 0.f, 0.f, 0.f}; }
    const bf16_t* ap = A + (size_t)r16 * lda + wave * kw + 8 * kq;
    const bf16_t* bp0 = B0 + (size_t)r16 * K + wave * kw + 8 * kq; const bf16_t* bp1 = B1 + (size_t)r16 * K + wave * kw + 8 * kq;
    if (NB == 1) {
#pragma unroll 4
    for (int k0 = 0; k0 < kw; k0 += 32) {
        const bf16x8 b0 = *(const bf16x8*)(bp0 + k0); bf16x8 b1 = b0; if (NB == 2) b1 = *(const bf16x8*)(bp1 + k0);
#pragma unroll
        for (int g = 0; g < 8; ++g) { const u32x4 a = *(const u32x4*)(ap + (size_t)(16 * g) * lda + k0);
            pa[0][g] = __builtin_amdgcn_mfma_f32_16x16x32_bf16(__builtin_bit_cast(bf16x8, a), b0, pa[0][g], 0, 0, 0);
            if (NB == 2) pa[NB - 1][g] = __builtin_amdgcn_mfma_f32_16x16x32_bf16(__builtin_bit_cast(bf16x8, a), b1, pa[NB - 1][g], 0, 0, 0);
            const float a0 = __uint_as_float(a.x << 16), a1 = __uint_as_float(a.x & 0xffff0000u), a2 = __uint_as_float(a.y << 16), a3 = __uint_as_float(a.y & 0xffff0000u);
            const float a4 = __uint_as_float(a.z << 16), a5 = __uint_as_float(a.z & 0xffff0000u), a6 = __uint_as_float(a.w << 16), a7 = __uint_as_float(a.w & 0xffff0000u);
            ps[g] += (a0 * a0 + a1 * a1) + (a2 * a2 + a3 * a3) + (a4 * a4 + a5 * a5) + (a6 * a6 + a7 * a7); }
    }
    } else {
#pragma unroll 2
    for (int k0 = 0; k0 < kw; k0 += 32) {
        const bf16x8 b0 = *(const bf16x8*)(bp0 + k0); bf16x8 b1 = b0; if (NB == 2) b1 = *(const bf16x8*)(bp1 + k0);
#pragma unroll
        for (int g = 0; g < 8; ++g) { const u32x4 a = *(const u32x4*)(ap + (size_t)(16 * g) * lda + k0);
            pa[0][g] = __builtin_amdgcn_mfma_f32_16x16x32_bf16(__builtin_bit_cast(bf16x8, a), b0, pa[0][g], 0, 0, 0);
            if (NB == 2) pa[NB - 1][g] = __builtin_amdgcn_mfma_f32_16x16x32_bf16(__builtin_bit_cast(bf16x8, a), b1, pa[NB - 1][g], 0, 0, 0);
            const float a0 = __uint_as_float(a.x << 16), a1 = __uint_as_float(a.x & 0xffff0000u), a2 = __uint_as_float(a.y << 16), a3 = __uint_as_float(a.y & 0xffff0000u);
            const float a4 = __uint_as_float(a.z << 16), a5 = __uint_as_float(a.z & 0xffff0000u), a6 = __uint_as_float(a.w << 16), a7 = __uint_as_float(a.w & 0xffff0000u);
            ps[g] += (a0 * a0 + a1 * a1) + (a2 * a2 + a3 * a3) + (a4 * a4 + a5 * a5) + (a6 * a6 + a7 * a7); }
    }
    }
    LAS f32x4* red = (LAS f32x4*)ldsl; LAS float* rs = (LAS float*)(ldsl + 131072 + 1024);
#pragma unroll
    for (int g = 0; g < 8; ++g) {
#pragma unroll
        for (int n = 0; n < NB; ++n) red[((wave * NB + n) * 8 + g) * 64 + lane] = pa[n][g];
        float s = ps[g]; s += __shfl_xor(s, 16); s += __shfl_xor(s, 32); if (kq == 0) rs[(wave * 8 + g) * 16 + r16] = s; }
    __syncthreads();
#pragma unroll
    for (int n = 0; n < NB; ++n) { f32x4 s = red[((0 * NB + n) * 8 + wave) * 64 + lane];
#pragma unroll
        for (int w = 1; w < 8; ++w) s += red[((w * NB + n) * 8 + wave) * 64 + lane];
        acc[n] = s; }
    { float s = 0.f;
#pragma unroll
      for (int w = 0; w < 8; ++w) s += rs[(w * 8 + wave) * 16 + r16];
      ssq = s; }
    __syncthreads();
}
__device__ __forceinline__ bf16_t f2bf1(float v) { return (bf16_t)(pg8::cvt_pk_bf16(v, 0.f) & 0xffffu); }
template <bool HAS_RS> __device__ __forceinline__ void sk_swiglu(LAS unsigned char* ldsl, const bf16_t* XBs, const bf16_t* WGU, bf16_t* Hs, int lane, int wave) {
    for (int t = blockIdx.x; t < DFF / 16; t += gridDim.x) {
        const int n0 = 256 * (t >> 3) + 16 * (t & 7); f32x4 acc[2]; float ssq;
        skinny_tile<2>(ldsl, XBs, DM, WGU + (size_t)n0 * DM, WGU + (size_t)(n0 + 128) * DM, DM, lane, wave, acc, ssq);
#pragma unroll
        for (int i = 0; i < 4; ++i) { const int rl = 4 * (lane >> 4) + i; const float rs = HAS_RS ? 1.0f / sqrtf(__shfl(ssq, rl) * (1.f / 1024.f) + EPS) : 1.0f;
            Hs[(size_t)(16 * wave + rl) * DFF + 16 * t + (lane & 15)] = f2bf1(silu_fast(acc[0][i] * rs) * (acc[1][i] * rs)); }
    }
}
__device__ __forceinline__ void sk_resid(LAS unsigned char* ldsl, const bf16_t* As, int K, const bf16_t* Wt, const float* bases, float* Xs, bf16_t* XBs, float scale, int lane, int wave) {
    for (int t = blockIdx.x; t < DM / 16; t += gridDim.x) {
        f32x4 acc[1]; float ssq;
        skinny_tile<1>(ldsl, As, K, Wt + (size_t)(16 * t) * K, Wt, K, lane, wave, acc, ssq);
#pragma unroll
        for (int i = 0; i < 4; ++i) { const size_t o = (size_t)(16 * wave + 4 * (lane >> 4) + i) * DM + 16 * t + (lane & 15); const float v = bases[o] + scale * acc[0][i]; Xs[o] = v; XBs[o] = f2bf1(v); }
    }
}
__device__ __forceinline__ void sk_proj(LAS unsigned char* ldsl, const bf16_t* X1Bs, const bf16_t* WINt, bf16_t* QGs, bf16_t* KGs, float* VSs, bf16_t* SGs, bf16_t* CQBs, float* CKVs, float* KPRs, float* ALOWs, int lane, int wave) {
    for (int t = blockIdx.x; t < 125; t += gridDim.x) {
        f32x4 acc[1]; float ssq;
        skinny_tile<1>(ldsl, X1Bs, DM, WINt + (size_t)(16 * t) * DM, WINt, DM, lane, wave, acc, ssq);
        const int c = 16 * t + (lane & 15);
#pragma unroll
        for (int i = 0; i < 4; ++i) { const int rl = 4 * (lane >> 4) + i; const size_t r = (size_t)(16 * wave + rl); const float v = acc[0][i] / sqrtf(__shfl(ssq, rl) * (1.f / 1024.f) + EPS);
            if (t < 16) QGs[r * 256 + c] = f2bf1(v * 0.125f);
            else if (t < 32) KGs[r * 256 + (c - 256)] = f2bf1(v);
            else if (t < 64) VSs[r * 512 + (c - 512)] = v;
            else if (t < 96) SGs[r * 512 + (c - 1024)] = f2bf1(silu_fast(v));
            else if (t < 112) CQBs[r * 256 + (c - 1536)] = f2bf1(v);
            else if (t < 120) CKVs[r * 128 + (c - 1792)] = v;
            else if (t < 124) KPRs[r * 64 + (c - 1920)] = v;
            else ALOWs[r * 16 + (c - 1984)] = v; }
    }
}
__device__ __forceinline__ void sk_qabs(LAS unsigned char* ldsl, const bf16_t* CQBs, const bf16_t* WQAt, bf16_t* QAs, int lane, int wave) {
    for (int t = blockIdx.x; t < 48; t += gridDim.x) {
        f32x4 acc[1]; float ssq;
        skinny_tile<1>(ldsl, CQBs, 256, WQAt + (size_t)(16 * t) * 256, WQAt, 256, lane, wave, acc, ssq);
#pragma unroll
        for (int i = 0; i < 4; ++i) { const int rl = 4 * (lane >> 4) + i; const float rq = QSCALE / sqrtf(__shfl(ssq, rl) * (1.f / 256.f) + EPS);
            QAs[(size_t)(16 * wave + rl) * 768 + 16 * t + (lane & 15)] = f2bf1(acc[0][i] * rq); }
    }
}

struct MapId { __device__ __forceinline__ int operator()(int n) const { return n; } };
struct MapGU { int off; __device__ __forceinline__ int operator()(int n) const { return 256 * (n >> 7) + (n & 127) + off; } };
struct MapWin { __device__ __forceinline__ int operator()(int n) const { return n < 1536 ? n : (n < 1552 ? n + 448 : n - 16); } };
template <class Map>
__device__ __forceinline__ void tr_item(const float* W, int K, int N, const float* kscale, bf16_t* WT, const Map map, LAS float* scr, int item, int lane, int ldk = 0) {
    if (ldk == 0) ldk = K;
    const int nblk = (N + 63) / 64, kb = item / nblk, nb = item - kb * nblk, k0 = 64 * kb, n0 = 64 * nb;
    const int c4 = lane & 15, kr = lane >> 4, nn = n0 + 4 * c4;
    f32x4 v[16];
#pragma unroll
    for (int i = 0; i < 16; ++i) { v[i] = (f32x4){0.f, 0.f, 0.f, 0.f}; if (nn < N) v[i] = *(const f32x4*)(W + (size_t)(k0 + kr + 4 * i) * N + nn); }
#pragma unroll
    for (int i = 0; i < 16; ++i) { const int kk = kr + 4 * i; const float s = kscale ? kscale[k0 + kk] : 1.0f; LAS float* d = scr + kk * 65 + 4 * c4; d[0] = v[i][0] * s; d[1] = v[i][1] * s; d[2] = v[i][2] * s; d[3] = v[i][3] * s; }
    asm volatile("s_waitcnt lgkmcnt(0)" ::: "memory");
    const int c = lane & 7;
#pragma unroll
    for (int j = 0; j < 8; ++j) { const int n = (lane >> 3) + 8 * j; const LAS float* s = scr + (8 * c) * 65 + n;
        u32x4 o; o.x = pg8::cvt_pk_bf16(s[0 * 65], s[1 * 65]); o.y = pg8::cvt_pk_bf16(s[2 * 65], s[3 * 65]); o.z = pg8::cvt_pk_bf16(s[4 * 65], s[5 * 65]); o.w = pg8::cvt_pk_bf16(s[6 * 65], s[7 * 65]);
        if (n0 + n < N) *(u32x4*)(WT + (size_t)map(n0 + n) * ldk + k0 + 8 * c) = o; }
    asm volatile("s_waitcnt lgkmcnt(0)" ::: "memory");
}

struct EpiVT { static constexpr bool PERM = true, AFTER_DRAIN = false;
    bf16_t* VT; const LAS float* tab;
    __device__ __forceinline__ void operator()(const f32x4 (&acc)[2][2][4][2], const pg8::Unit& u, int wr, int wc, int fr, int fq) const {
        const int tok0 = u.pn * 256 + wc * 32 + 8 * fq, bb = tok0 >> 11, t0 = tok0 & 2047;
        f32x4 rs[2][2];
#pragma unroll
        for (int bj = 0; bj < 2; ++bj)
#pragma unroll
            for (int n = 0; n < 2; ++n) rs[bj][n] = *(const LAS f32x4*)(tab + bj * 128 + wc * 32 + 8 * fq + 4 * n);
#pragma unroll
        for (int ai = 0; ai < 2; ++ai)
#pragma unroll
            for (int m = 0; m < 4; ++m) { const int cv = u.pm * 256 + ai * 128 + wr * 64 + m * 16 + fr;
                bf16_t* p = VT + ((size_t)((bb * 4 + (cv >> 7)) * 128 + (cv & 127))) * 2048 + t0;
#pragma unroll
                for (int bj = 0; bj < 2; ++bj) { const f32x4 o0 = acc[ai][bj][m][0] * rs[bj][0], o1 = acc[ai][bj][m][1] * rs[bj][1];
                    u32x4 w; w.x = pg8::cvt_pk_bf16(o0[0], o0[1]); w.y = pg8::cvt_pk_bf16(o0[2], o0[3]); w.z = pg8::cvt_pk_bf16(o1[0], o1[1]); w.w = pg8::cvt_pk_bf16(o1[2], o1[3]);
                    *(u32x4*)(p + bj * 128) = w; } }
    }
};
struct OneUnit { pg8::Unit u0;
    __device__ __forceinline__ bool next(int i, pg8::Unit& u) const { if (i != 0) return false; u = u0; return true; }
    __device__ __forceinline__ void a_ready(const pg8::Unit&) const {}
    __device__ __forceinline__ void done(const pg8::Unit&) const {}
};
struct SkipVOrder { pg8::StaticOrder S;
    __host__ __device__ void init(int M, int N, int G_, int c_) { S.init(M, N, G_, c_); }
    __host__ __device__ bool next(int i, pg8::Unit& u) const { if (!S.next(i, u)) return false; u.pn += u.pn >= 2 ? 2 : 0; return true; }
    __device__ __forceinline__ void a_ready(const pg8::Unit&) const {}
    __device__ __forceinline__ void done(const pg8::Unit&) const {}
};
template <class Sched> __device__ __forceinline__ RsTab build_rstab(LAS unsigned char* ldsl_, const Sched& S, const float* slots, int tid_) {
    RsTab T; T.p0 = T.p1 = T.p2 = T.p3 = -1; T.tab = (const LAS float*)(ldsl_ + RSTAB_OFF); int n = 0; pg8::Unit u;
    for (int i = 0; S.next(i, u); ++i) { if (u.pm != T.p0 && u.pm != T.p1 && u.pm != T.p2 && u.pm != T.p3) { if (n == 0) T.p0 = u.pm; else if (n == 1) T.p1 = u.pm; else if (n == 2) T.p2 = u.pm; else if (n == 3) T.p3 = u.pm; ++n; } }
    LAS float* tab = (LAS float*)(ldsl_ + RSTAB_OFF);
    const int rit = tid_ & 255, s0 = tid_ >> 8;
#pragma unroll
    for (int k = 0; k < 2; ++k) { const int s = s0 + 2 * k; const int pm = s == 0 ? T.p0 : (s == 1 ? T.p1 : (s == 2 ? T.p2 : T.p3)); if (pm >= 0) tab[s * 256 + rit] = rstd_from(slots, 16, pm * 256 + rit); }
    __syncthreads();
    return T;
}

struct Args { const void* in[26]; float* out; unsigned char* ws; int ph_lo, ph_hi, one, pad; };
constexpr int NPHASE = 11;

__global__ void __launch_bounds__(NTHR, 2) fwd_kernel(Args args) {
    extern __shared__ __attribute__((aligned(16))) unsigned char lds_raw[];
#define lds ((float*)lds_raw)
#define ldsl ((LAS unsigned char*)lds_raw)
#define MISC ((volatile LAS unsigned*)(ldsl + MISC_OFF))
#define tid ((int)threadIdx.x)
#define lane ((int)(threadIdx.x & 63u))
#define wave ((int)__builtin_amdgcn_readfirstlane((int)(threadIdx.x >> 6)))
#define gtid ((int)(blockIdx.x * NTHR + threadIdx.x))
#define gthr ((int)(gridDim.x * NTHR))
#define gw ((int)(blockIdx.x * (NTHR / 64)) + wave)
#define ngw ((int)(gridDim.x * (NTHR / 64)))
    if (tid < 32) MISC[tid] = 0u;
    __syncthreads();
    XcdBarrier bar; bar.bar = (unsigned*)args.ws + 4096; bar.x = 0; bar.st = nullptr;
    if (args.one) bar = xcd_barrier_post((unsigned*)args.ws + 4096, MISC + 8);

    float* out = args.out;
    unsigned char* ws = args.ws;
#define x_p ((const float*)((const float*)args.in[0]))
#define x_s ((const float*)((const float*)args.in[1]))
#define cache_kv ((const float*)((const float*)args.in[2]))
#define cache_pe ((const float*)((const float*)args.in[3]))
#define state_gla ((const float*)((const float*)args.in[4]))
#define page_table ((const int*)((const int*)args.in[5]))
#define f1n ((const float*)((const float*)args.in[6]))
#define f1g ((const float*)((const float*)args.in[7]))
#define f1u ((const float*)((const float*)args.in[8]))
#define f1d ((const float*)((const float*)args.in[9]))
#define mixn ((const float*)((const float*)args.in[10]))
#define w_in ((const float*)((const float*)args.in[11]))
#define w_a_up ((const float*)((const float*)args.in[12]))
#define b_a ((const float*)((const float*)args.in[13]))
#define gnw ((const float*)((const float*)args.in[14]))
#define qnw ((const float*)((const float*)args.in[15]))
#define w_uq ((const float*)((const float*)args.in[16]))
#define kvnw ((const float*)((const float*)args.in[17]))
#define w_uk ((const float*)((const float*)args.in[18]))
#define w_uv ((const float*)((const float*)args.in[19]))
#define w_out ((const float*)((const float*)args.in[20]))
#define f2n ((const float*)((const float*)args.in[21]))
#define f2g ((const float*)((const float*)args.in[22]))
#define f2u ((const float*)((const float*)args.in[23]))
#define f2d ((const float*)((const float*)args.in[24]))
#define fnw ((const float*)((const float*)args.in[25]))
#define WGU1 ((bf16_t*)((bf16_t*)(ws + B_WGU1)))
#define WD1 ((bf16_t*)((bf16_t*)(ws + B_WD1)))
#define WIN ((bf16_t*)((bf16_t*)(ws + B_WIN)))
#define WOUT ((bf16_t*)((bf16_t*)(ws + B_WOUT)))
#define WGU2 ((bf16_t*)((bf16_t*)(ws + B_WGU2)))
#define WD2 ((bf16_t*)((bf16_t*)(ws + B_WD2)))
#define XB ((bf16_t*)((bf16_t*)(ws + B_XB)))
#define SSQ0 ((float*)((float*)(ws + B_SSQ0)))
#define H ((bf16_t*)((bf16_t*)(ws + B_H)))
#define X1 ((float*)((float*)(ws + B_X1)))
#define X1B ((bf16_t*)((bf16_t*)(ws + B_X1B)))
#define SSQ1 ((float*)((float*)(ws + B_SSQ1)))
#define X2 ((float*)((float*)(ws + B_X2)))
#define X2B ((bf16_t*)((bf16_t*)(ws + B_X2B)))
#define SSQ2 ((float*)((float*)(ws + B_SSQ2)))
#define X3 ((float*)((float*)(ws + B_X3)))
#define X3B ((bf16_t*)((bf16_t*)(ws + B_X3B)))
#define SSQ3 ((float*)((float*)(ws + B_SSQ3)))
#define YMIXB ((bf16_t*)((bf16_t*)(ws + B_YMIXB)))
#define PROJ ((float*)((float*)(ws + B_PROJ)))
#define OG ((float*)((float*)(ws + B_OG)))
#define QF ((float*)((float*)(ws + B_QF)))
#define LAT ((float*)((float*)(ws + B_LAT)))
#define KPE ((float*)((float*)(ws + B_KPE)))
#define KN ((float*)((float*)(ws + B_KN)))
#define VV ((float*)((float*)(ws + B_VV)))
#define CQN ((float*)((float*)(ws + B_CQN)))
#define QLAT ((float*)((float*)(ws + B_QLAT)))
#define OLAT ((float*)((float*)(ws + B_OLAT)))
#define WQA ((bf16_t*)((bf16_t*)(ws + B_WQA)))
#define RT ((float2*)((float2*)(ws + B_RT)))
#define CQB ((bf16_t*)((bf16_t*)(ws + B_CQB)))
#define CQS ((float*)((float*)(ws + B_CQS)))
#define CKV ((float*)((float*)(ws + B_CKV)))
#define KPR ((float*)((float*)(ws + B_KPR)))
#define KL ((bf16_t*)((bf16_t*)(ws + B_KL)))
#define QA ((bf16_t*)((bf16_t*)(ws + B_QA)))
#define QG ((bf16_t*)((bf16_t*)(ws + B_QG)))
#define KG ((bf16_t*)((bf16_t*)(ws + B_KG)))
#define VT ((bf16_t*)((bf16_t*)(ws + B_VT)))
#define VS ((float*)((float*)(ws + B_VS)))
#define SG ((bf16_t*)((bf16_t*)(ws + B_SG)))
#define ALOW ((float*)((float*)(ws + B_ALOW)))
#define DEC ((float*)((float*)(ws + B_DEC)))
#define UT ((bf16_t*)(ws + B_UT))
#define ST ((bf16_t*)((bf16_t*)(ws + B_ST)))
#define PART ((float*)(ws + B_PART))
    const Rows2 Xin{x_p, x_s, MP, DM};

    const int lo = args.ph_lo, hi = args.ph_hi;
#define IN(k) (lo <= (k) && (k) < hi)
#define SEAM(k) do { if (IN(k) && IN((k) + 1)) xcd_barrier(bar); } while (0)

    if (IN(0)) {
        LAS float* scr = (LAS float*)ldsl + wave * 4160;
        constexpr int I_G = 16 * 44, I_D = 44 * 16, I_IN = 16 * 32, I_OUT = 8 * 16;
        constexpr int NIT = 6 * I_G + I_IN + I_OUT;
        static_assert(I_G == I_D, "items");
        for (int it = gw; it < NIT; it += ngw) {
            int r = it;
            if (r < I_G) { tr_item(f1g, DM, DFF, f1n, WGU1, MapGU{0}, scr, r, lane); continue; } r -= I_G;
            if (r < I_G) { tr_item(f1u, DM, DFF, f1n, WGU1, MapGU{128}, scr, r, lane); continue; } r -= I_G;
            if (r < I_D) { tr_item(f1d, DFF, DM, nullptr, WD1, MapId{}, scr, r, lane); continue; } r -= I_D;
            if (r < I_G) { tr_item(f2g, DM, DFF, f2n, WGU2, MapGU{0}, scr, r, lane); continue; } r -= I_G;
            if (r < I_G) { tr_item(f2u, DM, DFF, f2n, WGU2, MapGU{128}, scr, r, lane); continue; } r -= I_G;
            if (r < I_D) { tr_item(f2d, DFF, DM, nullptr, WD2, MapId{}, scr, r, lane); continue; } r -= I_D;
            if (r < I_IN) { tr_item(w_in, DM, INW, mixn, WIN, MapWin{}, scr, r, lane); continue; } r -= I_IN;
            tr_item(w_out, 512, DM, nullptr, WOUT, MapId{}, scr, r, lane, DM);
        }
        for (int it = gw; it < 2048; it += ngw) { const int ng = it & 15, cg = (it >> 4) & 31, h = it >> 9, n = ng * 64 + lane;
            const float* wv = w_uv + (size_t)(cg * 4) * 512 + h * 128; const float* wo = w_out + (size_t)(512 + h * 128) * DM + n; float s0 = 0.f, s1 = 0.f, s2 = 0.f, s3 = 0.f;
#pragma unroll 32
            for (int d = 0; d < 128; ++d) { const float o = wo[(size_t)d * DM]; s0 += wv[d] * o; s1 += wv[512 + d] * o; s2 += wv[1024 + d] * o; s3 += wv[1536 + d] * o; }
            u32x2 w; w.x = pg8::cvt_pk_bf16(s0, s1); w.y = pg8::cvt_pk_bf16(s2, s3); *(u32x2*)(WOUT + (size_t)n * DM + 512 + h * 128 + cg * 4) = w; }
        for (int it = wave * (int)gridDim.x + (int)blockIdx.x; it < 512; it += ngw) { const int kg4 = it & 3, cg = (it >> 2) & 31, h = it >> 7, k = kg4 * 64 + lane;
            const f32x4* wq = (const f32x4*)(w_uq + (size_t)k * 768 + h * 192); const float* wk = w_uk + (size_t)(cg * 4) * 512 + h * 128; float s0 = 0.f, s1 = 0.f, s2 = 0.f, s3 = 0.f;
#pragma unroll 16
            for (int d4 = 0; d4 < 32; ++d4) { const f32x4 q = wq[d4];
#pragma unroll
                for (int e = 0; e < 4; ++e) { const int d = 4 * d4 + e; s0 += q[e] * wk[d]; s1 += q[e] * wk[512 + d]; s2 += q[e] * wk[1024 + d]; s3 += q[e] * wk[1536 + d]; } }
            const float g = qnw[k]; bf16_t* dst = WQA + (size_t)(h * 128 + cg * 4) * 256 + k;
            const unsigned lo = pg8::cvt_pk_bf16(s0 * g, s1 * g), hi = pg8::cvt_pk_bf16(s2 * g, s3 * g);
            dst[0] = (bf16_t)(lo & 0xffffu); dst[256] = (bf16_t)(lo >> 16); dst[512] = (bf16_t)(hi & 0xffffu); dst[768] = (bf16_t)(hi >> 16); }
        for (int e = gtid; e < 256 * 256; e += gthr) { const int k = e & 255, rr = e >> 8, h = rr >> 6, j = rr & 63, i = j >> 1, ee = j & 1;
            WQA[(size_t)(512 + rr) * 256 + k] = (bf16_t)(pg8::cvt_pk_bf16(w_uq[(size_t)k * 768 + h * 192 + 128 + 32 * ee + i] * qnw[k], 0.f) & 0xffffu); }
        for (int e = gtid; e < 2049 * 32; e += gthr) { const int i = e & 31, p = e >> 5; float c, s; rope_cs(p < SEQ ? p : PAST, i, c, s); RT[e] = make_float2(c, s); }
        for (int e = gtid; e < 48 * 1024 / 8; e += gthr) ((u32x4*)(WIN + (size_t)2000 * 1024))[e] = (u32x4){0u, 0u, 0u, 0u};
        for (int r4 = gw; r4 < MT / 4; r4 += ngw) {
            float4 v[4][4]; float s[4];
#pragma unroll
            for (int q = 0; q < 4; ++q) { const float4* p = (const float4*)Xin.row(4 * r4 + q) + lane;
#pragma unroll
                for (int j = 0; j < 4; ++j) v[q][j] = p[64 * j]; }
#pragma unroll
            for (int q = 0; q < 4; ++q) { s[q] = 0.f;
#pragma unroll
                for (int j = 0; j < 4; ++j) s[q] += (v[q][j].x * v[q][j].x + v[q][j].y * v[q][j].y) + (v[q][j].z * v[q][j].z + v[q][j].w * v[q][j].w); }
#pragma unroll
            for (int o = 1; o < 64; o <<= 1) {
#pragma unroll
                for (int q = 0; q < 4; ++q) s[q] += __shfl_xor(s[q], o); }
#pragma unroll
            for (int q = 0; q < 4; ++q) { const float rs = 1.0f / sqrtf(s[q] * (1.f / 1024.f) + EPS);
#pragma unroll
                for (int j = 0; j < 4; ++j) { u32x2 w; w.x = pg8::cvt_pk_bf16(v[q][j].x * rs, v[q][j].y * rs); w.y = pg8::cvt_pk_bf16(v[q][j].z * rs, v[q][j].w * rs); ((u32x2*)(XB + (size_t)(4 * r4 + q) * DM))[lane + 64 * j] = w; } }
        }
    } SEAM(0);
    if (IN(1)) {
        sk_swiglu<false>(ldsl, XB + (size_t)MP * DM, WGU1, H + (size_t)MP * DFF, lane, wave);
        pg8::Gemm g{XB, WGU1, MP, 2 * DFF, DM}; pg8::StaticOrder S; S.init(MP, 2 * DFF, gridDim.x, (int)blockIdx.x);
        EpiSwigluB<false> E{H, SSQ0, 1, RsTab{-1, -1, -1, -1, nullptr}}; pg8::gemm_phase<EpiSwigluB<false>, pg8::StaticOrder, PG8_ALIGN, PG8_SP2>(ldsl, g, S, E); } SEAM(1);
    if (IN(2)) {
        sk_resid(ldsl, H + (size_t)MP * DFF, DFF, WD1, x_s, X1 + (size_t)MP * DM, X1B + (size_t)MP * DM, 0.5f, lane, wave);
        pg8::Gemm g{H, WD1, MP, DM, DFF}; pg8::StaticOrder S; S.init(MP, DM, gridDim.x, (int)blockIdx.x);
        EpiResidB<false> E{x_p, nullptr, X1B, SSQ1, 0.5f}; pg8::gemm_phase<EpiResidB<false>, pg8::StaticOrder, PG8_ALIGN, PG8_SP2>(ldsl, g, S, E); } SEAM(2);
    if (IN(3)) {
        sk_proj(ldsl, X1B + (size_t)MP * DM, WIN, QG + (size_t)MP * 256, KG + (size_t)MP * 256, VS, SG + (size_t)MP * 512, CQB + (size_t)MP * 256, CKV + (size_t)MP * 128, KPR + (size_t)MP * 64, ALOW + (size_t)MP * 16, lane, wave);
        { pg8::Gemm g{X1B, WIN, MP, 2048, DM}; SkipVOrder S; S.init(MP, 1536, gridDim.x, (int)blockIdx.x);
          const RsTab RT3 = build_rstab(ldsl, S, SSQ1, tid); EpiProj2 E{PROJ, SSQ1, RT3, CQB, CQS, CKV, KPR, QG, KG, VT, VS, SG, ALOW}; pg8::gemm_phase<EpiProj2, SkipVOrder, PG8_ALIGN, PG8_SP2>(ldsl, g, S, E); }
        { pg8::Gemm gv{WIN + (size_t)C_V * DM, X1B, 512, MP, DM};
          pg8::Unit uv; LAS float* tab = (LAS float*)(ldsl + RSTAB_OFF);
#pragma unroll 1
          for (int L = (int)blockIdx.x; L < 256; L += (int)gridDim.x) { const int wg = (L & 7) * 32 + (L >> 3); uv.pm = wg & 1; uv.pn = wg >> 1;
              __syncthreads();
              if (tid < 256) tab[tid] = rstd_from(SSQ1, 16, uv.pn * 256 + tid);
              __syncthreads();
              OneUnit O1{uv}; EpiVT EV{VT, (const LAS float*)tab}; pg8::gemm_phase<EpiVT, OneUnit, PG8_ALIGN, PG8_SP2>(ldsl, gv, O1, EV); } } } SEAM(3);
    if (IN(4)) {
        for (int r4 = gw; r4 < MT / 4; r4 += ngw) {
            float2 cv[4]; float x1[4], x2[4]; float2 cs[4]; float ss[4];
#pragma unroll
            for (int q = 0; q < 4; ++q) { const int r = 4 * r4 + q; const int pidx = r < MP ? (r & (SEQ - 1)) : SEQ;
                cv[q] = *(const float2*)(CKV + (size_t)r * 128 + lane * 2);
                x1[q] = KPR[(size_t)r * 64 + (lane & 31)]; x2[q] = KPR[(size_t)r * 64 + 32 + (lane & 31)]; cs[q] = RT[(size_t)pidx * 32 + (lane & 31)]; }
#pragma unroll
            for (int q = 0; q < 4; ++q) ss[q] = cv[q].x * cv[q].x + cv[q].y * cv[q].y;
#pragma unroll
            for (int o = 1; o < 64; o <<= 1) {
#pragma unroll
                for (int q = 0; q < 4; ++q) ss[q] += __shfl_xor(ss[q], o); }
            const float2 w = *(const float2*)(kvnw + lane * 2);
#pragma unroll
            for (int q = 0; q < 4; ++q) { const int r = 4 * r4 + q;
                const float rstd = 1.0f / sqrtf(ss[q] * (1.f / 128.f) + EPS);
                const float2 y = make_float2(cv[q].x * rstd * w.x, cv[q].y * rstd * w.y);
                float* o = r < MP ? out + O_KVP + (size_t)r * 128 : out + O_KVS + (size_t)(r - MP) * 128;
                *(float2*)(o + lane * 2) = y;
                *(unsigned*)(KL + (size_t)r * 192 + lane * 2) = pg8::cvt_pk_bf16(y.x, y.y);
                if (lane < 32) {
                    const float y1 = x1[q] * cs[q].x - x2[q] * cs[q].y, y2 = x1[q] * cs[q].y + x2[q] * cs[q].x;
                    float* op = r < MP ? out + O_PEP + (size_t)r * 64 : out + O_PES + (size_t)(r - MP) * 64;
                    op[lane] = y1; op[32 + lane] = y2;
                    *(unsigned*)(KL + (size_t)r * 192 + 128 + 2 * lane) = pg8::cvt_pk_bf16(y1, y2); } }
        }
        for (int u = gw; u < 2048; u += ngw) gla_prep_unit(ldsl + wave * KTT_BYTES, QG, KG, ALOW, w_a_up, b_a, VT, DEC, UT, u, lane);
        __syncthreads();
        { pg8::Gemm g{CQB, WQA, MP, 768, 256}; pg8::StaticOrder S; S.init(MP, 768, gridDim.x, (int)blockIdx.x);
          EpiQabs E{QA, CQS, RT}; pg8::gemm_phase<EpiQabs, pg8::StaticOrder, PG8_ALIGN, PG8_SP2>(ldsl, g, S, E); }
        sk_qabs(ldsl, CQB + (size_t)MP * 256, WQA, QA + (size_t)MP * 768, lane, wave);
    } SEAM(4);
    if (IN(5)) {
        const bool memfirst = ((blockIdx.x >> 3) & 1) != 0;
        if (memfirst) {
        for (int it = blockIdx.x; it < 256; it += gridDim.x) decode_item_mfma(ldsl, QA, RT, cache_kv, cache_pe, page_table, PART, it, tid, lane, wave);
        }
        for (int p2 = 2 * blockIdx.x; p2 < 512; p2 += 2 * gridDim.x)
#pragma unroll 1
            for (int hf = 0; hf < 2; ++hf) { const int p = p2 >> 1, b = p >> 4, qq = p & 15; mla_attn_unit(ldsl, QA, KL, RT, YMIXB, b, hf ? qq : 31 - qq, tid, lane, wave); }
        __syncthreads();
        if (!memfirst) {
        for (int it = blockIdx.x; it < 256; it += gridDim.x) decode_item_mfma(ldsl, QA, RT, cache_kv, cache_pe, page_table, PART, it, tid, lane, wave);
        }
        for (int e0 = gtid; e0 < 64 * 64 * 64; e0 += gthr) { const int d = e0 & 63, vp = (e0 >> 6) & 63, bh = e0 >> 12;
            const size_t b0 = (size_t)(bh * 32) * 8192 + (size_t)(2 * vp) * 64 + d;
            bf16_t u0[32], u1[32]; float dc[32];
#pragma unroll
            for (int c = 0; c < 32; ++c) { u0[c] = UT[b0 + (size_t)c * 8192]; u1[c] = UT[b0 + (size_t)c * 8192 + 64]; dc[c] = DEC[(size_t)(bh * 32 + c) * 64 + d]; }
            float S0 = 0.f, S1 = 0.f; bf16_t s0[32], s1[32];
#pragma unroll
            for (int c = 0; c < 32; ++c) { const unsigned pk = pg8::cvt_pk_bf16(S0, S1); s0[c] = (bf16_t)(pk & 0xffffu); s1[c] = (bf16_t)(pk >> 16);
                S0 = dc[c] * (S0 + bf2f(u0[c])); S1 = dc[c] * (S1 + bf2f(u1[c])); }
#pragma unroll
            for (int c = 0; c < 32; ++c) { ST[b0 + (size_t)c * 8192] = s0[c]; ST[b0 + (size_t)c * 8192 + 64] = s1[c]; }
            out[O_GLP + ((size_t)bh * 64 + d) * 128 + 2 * vp] = S0; out[O_GLP + ((size_t)bh * 64 + d) * 128 + 2 * vp + 1] = S1;
        }
        for (int it = wave * (int)gridDim.x + (int)blockIdx.x; it < MS * 4; it += ngw) {
            const int h = it & 3, bb = it >> 2; const size_t row = (size_t)MP + bb;
            float xg = b_a[h * 64 + lane];
#pragma unroll
            for (int r = 0; r < 16; ++r) xg += ALOW[row * 16 + r] * w_a_up[r * 256 + h * 64 + lane];
            const int ad = __float_as_int(expf(logsig_f(xg) * (1.f / 16.f))), qd = __float_as_int(bf2f(QG[row * 256 + h * 64 + lane])), kd = __float_as_int(bf2f(KG[row * 256 + h * 64 + lane]));
            const float2 vv = *(const float2*)(VS + (size_t)bb * 512 + h * 128 + 2 * lane);
            const float* st = state_gla + ((size_t)(bb * 4 + h) * 64) * 128 + 2 * lane; float* dst = out + O_GLS + ((size_t)(bb * 4 + h) * 64) * 128 + 2 * lane;
            float o0 = 0.f, o1 = 0.f;
            float2 sv[64];
#pragma unroll
            for (int dd = 0; dd < 64; ++dd) sv[dd] = *(const float2*)(st + dd * 128);
#pragma unroll
            for (int dd = 0; dd < 64; ++dd) { const float a = __int_as_float(__builtin_amdgcn_readlane(ad, dd)), q = __int_as_float(__builtin_amdgcn_readlane(qd, dd)), k = __int_as_float(__builtin_amdgcn_readlane(kd, dd));
                const float S0 = a * sv[dd].x + k * vv.x, S1 = a * sv[dd].y + k * vv.y; o0 += q * S0; o1 += q * S1; *(float2*)(dst + dd * 128) = make_float2(S0, S1); }
            const float rstd = 1.0f / sqrtf(wave_sum(o0 * o0 + o1 * o1) * (1.f / 128.f) + EPS);
            const float2 gn = *(const float2*)(gnw + 2 * lane); const unsigned sg = *(const unsigned*)(SG + row * 512 + h * 128 + 2 * lane);
            *(unsigned*)(YMIXB + row * DM + h * 128 + 2 * lane) = pg8::cvt_pk_bf16(o0 * rstd * gn.x * __uint_as_float(sg << 16), o1 * rstd * gn.y * __uint_as_float(sg & 0xffff0000u));
        }
    } SEAM(5);
    if (IN(6)) {
        for (int u = gw; u < 4096; u += ngw) gla_out_unit(ldsl + wave * GD_BYTES, QG, KG, VT, ST, SG, gnw, YMIXB, u, lane);
        for (int e = gw; e < MS * 4; e += ngw) { const int h = e & 3, bs = e >> 2; const size_t qrow = (size_t)(MP + bs);
            float part;
            {   const unsigned ql = *(const unsigned*)(QA + qrow * 768 + h * 128 + 2 * lane), kl = *(const unsigned*)(KL + qrow * 192 + 2 * lane);
                part = __uint_as_float(ql << 16) * __uint_as_float(kl << 16) + __uint_as_float(ql & 0xffff0000u) * __uint_as_float(kl & 0xffff0000u); }
            if (lane < 32) { const unsigned qp = *(const unsigned*)(QA + qrow * 768 + 512 + h * 64 + 2 * lane), kp = *(const unsigned*)(KL + qrow * 192 + 128 + 2 * lane); const float2 cs = RT[(size_t)SEQ * 32 + lane];
                const float x1 = __uint_as_float(qp << 16), x2 = __uint_as_float(qp & 0xffff0000u); part += (x1 * cs.x - x2 * cs.y) * __uint_as_float(kp << 16) + (x1 * cs.y + x2 * cs.x) * __uint_as_float(kp & 0xffff0000u); }
            const float sn = wave_sum(part);
            const float* p0 = PART + (size_t)((bs * 2) * 4 + h) * 132; const float* p1 = PART + (size_t)((bs * 2 + 1) * 4 + h) * 132;
            const float M0 = p0[128], M1 = p1[128], M = fmaxf(fmaxf(M0, M1), sn), f0 = __builtin_amdgcn_exp2f(M0 - M), f1 = __builtin_amdgcn_exp2f(M1 - M), fn = __builtin_amdgcn_exp2f(sn - M);
            const float il = 1.0f / (p0[129] * f0 + p1[129] * f1 + fn);
            const unsigned vl = *(const unsigned*)(KL + qrow * 192 + 2 * lane);
            const float2 a0 = *(const float2*)(p0 + 2 * lane), a1 = *(const float2*)(p1 + 2 * lane);
            const float o0 = (a0.x * f0 + a1.x * f1 + fn * __uint_as_float(vl << 16)) * il, o1 = (a0.y * f0 + a1.y * f1 + fn * __uint_as_float(vl & 0xffff0000u)) * il;
            *(unsigned*)(YMIXB + qrow * DM + 512 + h * 128 + 2 * lane) = pg8::cvt_pk_bf16(o0, o1); }
    } SEAM(6);
    if (IN(7)) {
        sk_resid(ldsl, YMIXB + (size_t)MP * DM, DM, WOUT, X1 + (size_t)MP * DM, X2 + (size_t)MP * DM, X2B + (size_t)MP * DM, 1.0f, lane, wave);
        pg8::Gemm g{YMIXB, WOUT, MP, DM, DM}; pg8::StaticOrder S; S.init(MP, DM, gridDim.x, (int)blockIdx.x);
        EpiResidB<true> E{nullptr, X1B, X2B, SSQ2, 1.0f}; pg8::gemm_phase<EpiResidB<true>, pg8::StaticOrder, PG8_ALIGN, PG8_SP2>(ldsl, g, S, E); } SEAM(7);
    if (IN(8)) {
        sk_swiglu<true>(ldsl, X2B + (size_t)MP * DM, WGU2, H + (size_t)MP * DFF, lane, wave);
        pg8::Gemm g{X2B, WGU2, MP, 2 * DFF, DM}; pg8::StaticOrder S; S.init(MP, 2 * DFF, gridDim.x, (int)blockIdx.x);
        const RsTab RT8 = build_rstab(ldsl, S, SSQ2, tid); EpiSwigluB<true> E{H, SSQ2, 16, RT8}; pg8::gemm_phase<EpiSwigluB<true>, pg8::StaticOrder, PG8_ALIGN, PG8_SP2>(ldsl, g, S, E); } SEAM(8);
    if (IN(9)) {
        sk_resid(ldsl, H + (size_t)MP * DFF, DFF, WD2, X2 + (size_t)MP * DM, X3 + (size_t)MP * DM, X3B + (size_t)MP * DM, 0.5f, lane, wave);
        pg8::Gemm g{H, WD2, MP, DM, DFF}; pg8::StaticOrder S; S.init(MP, DM, gridDim.x, (int)blockIdx.x);
        EpiResidB<true> E{nullptr, X2B, X3B, SSQ3, 0.5f}; pg8::gemm_phase<EpiResidB<true>, pg8::StaticOrder, PG8_ALIGN, PG8_SP2>(ldsl, g, S, E); } SEAM(9);
    if (IN(10)) {
        for (int r4 = gw; r4 < MP / 8; r4 += ngw) {
            u32x4 raw[8][2]; float s[8];
#pragma unroll
            for (int q = 0; q < 8; ++q)
#pragma unroll
                for (int j = 0; j < 2; ++j) raw[q][j] = *(const u32x4*)(X3B + (size_t)(8 * r4 + q) * DM + 512 * j + 8 * lane);
            f32x4 w[4];
#pragma unroll
            for (int j = 0; j < 2; ++j) { w[2 * j] = *(const f32x4*)(fnw + 512 * j + 8 * lane); w[2 * j + 1] = *(const f32x4*)(fnw + 512 * j + 8 * lane + 4); }
#pragma unroll
            for (int q = 0; q < 8; ++q) { s[q] = 0.f;
#pragma unroll
                for (int j = 0; j < 2; ++j)
#pragma unroll
                    for (int e = 0; e < 4; ++e) { const unsigned u = raw[q][j][e]; const float a = __uint_as_float(u << 16), b = __uint_as_float(u & 0xffff0000u); s[q] += a * a + b * b; } }
#pragma unroll
            for (int o = 1; o < 64; o <<= 1) {
#pragma unroll
                for (int q = 0; q < 8; ++q) s[q] += __shfl_xor(s[q], o); }
#pragma unroll
            for (int q = 0; q < 8; ++q) { const float rstd = 1.0f / sqrtf(s[q] * (1.f / 1024.f) + EPS);
#pragma unroll
                for (int j = 0; j < 2; ++j) { const u32x4 u = raw[q][j];
                    const f32x4 v0 = (f32x4){__uint_as_float(u.x << 16), __uint_as_float(u.x & 0xffff0000u), __uint_as_float(u.y << 16), __uint_as_float(u.y & 0xffff0000u)};
                    const f32x4 v1 = (f32x4){__uint_as_float(u.z << 16), __uint_as_float(u.z & 0xffff0000u), __uint_as_float(u.w << 16), __uint_as_float(u.w & 0xffff0000u)};
                    float* op = out + O_YP + (size_t)(8 * r4 + q) * DM + 512 * j + 8 * lane;
                    *(f32x4*)op = v0 * rstd * w[2 * j]; *(f32x4*)(op + 4) = v1 * rstd * w[2 * j + 1]; } }
        }
        rms_rows_1024(Rows2{X3 + (size_t)MP * DM, X3 + (size_t)MP * DM, MS, DM}, fnw, out + O_YS, MS);
    }
#undef IN
#undef SEAM
}
#undef lds
#undef ldsl
#undef MISC
#undef tid
#undef lane
#undef wave
#undef gtid
#undef gthr
#undef gw
#undef ngw
#undef x_p
#undef x_s
#undef cache_kv
#undef cache_pe
#undef state_gla
#undef page_table
#undef f1n
#undef f1g
#undef f1u
#undef f1d
#undef mixn
#undef w_in
#undef w_a_up
#undef b_a
#undef gnw
#undef qnw
#undef w_uq
#undef kvnw
#undef w_uk
#undef w_uv
#undef w_out
#undef f2n
#undef f2g
#undef f2u
#undef f2d
#undef fnw
#undef WGU1
#undef WD1
#undef WIN
#undef WOUT
#undef WGU2
#undef WD2
#undef XB
#undef SSQ0
#undef H
#undef X1
#undef X1B
#undef SSQ1
#undef X2
#undef X2B
#undef SSQ2
#undef X3
#undef X3B
#undef SSQ3
#undef YMIXB
#undef PROJ
#undef OG
#undef QF
#undef LAT
#undef KPE
#undef KN
#undef VV
#undef CQN
#undef QLAT
#undef OLAT
#undef WQA
#undef RT
#undef CQB
#undef CQS
#undef CKV
#undef KPR
#undef KL
#undef QA
#undef QG
#undef KG
#undef VT
#undef VS
#undef SG
#undef ALOW
#undef DEC
#undef UT
#undef ST
#undef PART

extern "C" void kernel_launch(void* const* d_in, const int* in_sizes, int n_in, void* d_out, int out_size, void* d_ws, size_t ws_size, hipStream_t stream) {
    static int grid = 0;
    if (grid == 0) {
        if (n_in != 26 || (size_t)out_size != O_END || ws_size < B_END) { fprintf(stderr, "kernel_launch: unexpected sizes n_in %d out %d ws %zu (need %zu)\n", n_in, out_size, ws_size, (size_t)B_END); grid = -1; return; }
        int dev = 0, cus = 0;
        if (hipGetDevice(&dev) != hipSuccess || hipDeviceGetAttribute(&cus, hipDeviceAttributeMultiprocessorCount, dev) != hipSuccess) { grid = -1; return; }
        if (hipFuncSetAttribute((const void*)fwd_kernel, hipFuncAttributeMaxDynamicSharedMemorySize, LDS_BYTES) != hipSuccess) { fprintf(stderr, "hipFuncSetAttribute failed\n"); grid = -1; return; }
        int per_cu = 0;
        if (hipOccupancyMaxActiveBlocksPerMultiprocessor(&per_cu, (const void*)fwd_kernel, NTHR, LDS_BYTES) != hipSuccess || per_cu < 1) fprintf(stderr, "occupancy query: %d\n", per_cu);
        (void)hipGetLastError();
        grid = cus;
    }
    if (grid < 0) return;
    (void)hipMemsetAsync(d_ws, 0, WS_CTL_BYTES, stream);
    Args a{};
    for (int i = 0; i < 26; ++i) a.in[i] = d_in[i];
    a.out = (float*)d_out; a.ws = (unsigned char*)d_ws; a.pad = 0;
#if MK_ONE_LAUNCH
    a.ph_lo = 0; a.ph_hi = NPHASE; a.one = 1;
    hipLaunchKernelGGL(fwd_kernel, dim3(grid), dim3(NTHR), LDS_BYTES, stream, a);
#else
    for (int p = 0; p < NPHASE; ++p) { a.ph_lo = p; a.ph_hi = p + 1; a.one = 0; hipLaunchKernelGGL(fwd_kernel, dim3(grid), dim3(NTHR), LDS_BYTES, stream, a); }
#endif
}
```

```cpp
#include <hip/hip_runtime.h>
#include <cstdio>
#include <cstdint>

#ifndef MK_ONE_LAUNCH
#define MK_ONE_LAUNCH 1
#endif

constexpr int DM = 1024, BATCH = 16, SEQ = 2048, DECB = 128, PAST = 8192, PAGE = 128, NPAGES = PAST / PAGE;
constexpr int DFF = 2816, INW = 2000;
constexpr int MP = BATCH * SEQ, MS = DECB, MT = MP + MS;
constexpr int MPAD = 33024, PAD_PM = 128;
constexpr float EPS = 1e-6f;
constexpr float MLA_SCALE = 0.07216878364870322f;
constexpr int C_Q = 0, C_K = 256, C_V = 512, C_G = 1024, C_A = 1536, C_CQ = 1552, C_CKV = 1808, C_KPE = 1936;
constexpr size_t O_YP = 0, O_YS = (size_t)MP * DM, O_KVP = O_YS + (size_t)MS * DM, O_PEP = O_KVP + (size_t)MP * 128, O_GLP = O_PEP + (size_t)MP * 64,
                 O_KVS = O_GLP + (size_t)BATCH * 4 * 64 * 128, O_PES = O_KVS + (size_t)MS * 128, O_GLS = O_PES + (size_t)MS * 64, O_END = O_GLS + (size_t)MS * 4 * 64 * 128;

constexpr size_t al256(size_t x) { return (x + 255) & ~(size_t)255; }
constexpr size_t WS_CTL_BYTES = 1u << 20;
constexpr size_t B_WGU1 = WS_CTL_BYTES, B_WD1 = B_WGU1 + (size_t)5632 * 1024 * 2, B_WIN = B_WD1 + (size_t)1024 * 2816 * 2, B_WOUT = B_WIN + (size_t)2048 * 1024 * 2,
                 B_WGU2 = B_WOUT + (size_t)1024 * 1024 * 2, B_WD2 = B_WGU2 + (size_t)5632 * 1024 * 2, B_XB = B_WD2 + (size_t)1024 * 2816 * 2,
                 B_SSQ0 = B_XB + (size_t)MPAD * DM * 2, B_H = al256(B_SSQ0 + (size_t)MPAD * 4), B_X1 = B_H + (size_t)MPAD * DFF * 2, B_X1B = B_X1 + (size_t)MPAD * DM * 4,
                 B_SSQ1 = B_X1B + (size_t)MPAD * DM * 2, B_X2 = B_SSQ1 + (size_t)MPAD * 64, B_X2B = B_X2 + (size_t)MPAD * DM * 4, B_SSQ2 = B_X2B + (size_t)MPAD * DM * 2,
                 B_X3 = B_SSQ2 + (size_t)MPAD * 64, B_X3B = B_X3 + (size_t)MPAD * DM * 4, B_SSQ3 = B_X3B + (size_t)MPAD * DM * 2, B_YMIXB = B_SSQ3 + (size_t)MPAD * 64,
                 B_PROJ = B_YMIXB + (size_t)MPAD * DM * 2, B_OG = B_PROJ + (size_t)MT * INW * 4, B_QF = B_OG + (size_t)MT * 512 * 4, B_LAT = B_QF + (size_t)MT * 768 * 4,
                 B_KPE = B_LAT + (size_t)MT * 128 * 4, B_KN = B_KPE + (size_t)MT * 64 * 4, B_VV = B_KN + (size_t)MT * 512 * 4, B_CQN = B_VV + (size_t)MT * 512 * 4,
                 B_QLAT = B_CQN + (size_t)MT * 256 * 4, B_OLAT = B_QLAT + (size_t)MS * 512 * 4,
                 B_WQA = al256(B_OLAT + (size_t)MS * 512 * 4), B_RT = B_WQA + (size_t)768 * 256 * 2, B_CQB = al256(B_RT + (size_t)2049 * 32 * 8), B_CQS = B_CQB + (size_t)MPAD * 256 * 2,
                 B_CKV = B_CQS + (size_t)MPAD * 16, B_KPR = B_CKV + (size_t)MPAD * 128 * 4, B_KL = B_KPR + (size_t)MPAD * 64 * 4, B_QA = B_KL + (size_t)MPAD * 192 * 2,
                 B_QG = B_QA + (size_t)MPAD * 768 * 2, B_KG = B_QG + (size_t)MPAD * 256 * 2, B_VT = B_KG + (size_t)MPAD * 256 * 2, B_VS = B_VT + (size_t)64 * 128 * 2048 * 2,
                 B_SG = B_VS + (size_t)MS * 512 * 4, B_ALOW = B_SG + (size_t)MPAD * 512 * 2, B_DEC = B_ALOW + (size_t)MPAD * 16 * 4, B_UT = B_DEC + (size_t)2048 * 64 * 4,
                 B_ST = B_UT + (size_t)2048 * 128 * 64 * 4, B_PART = B_ST + (size_t)2048 * 128 * 64 * 2, B_END = B_PART + (size_t)256 * 4 * 132 * 4;

#define LAS __attribute__((address_space(3)))
constexpr int NTHR = 512;
constexpr int LDS_BYTES = 147456;
constexpr int MISC_OFF = 147456 - 256;

#define XB_TMO      128
#define XB_XCNT(j)  (256  + 64 * (j))
#define XB_XSUB(j)  (1280 + 64 * (j))
#define XB_XGEN(j)  (2304 + 64 * (j))
#define XB_TOP      3328
#define XB_TOPGEN   3392
#define XCD_BAR_WORDS 3456
#define XB_SPIN_CAP (1u << 25)
__device__ __forceinline__ unsigned xb_ld(unsigned* p)              { return __hip_atomic_load(p, __ATOMIC_RELAXED, __HIP_MEMORY_SCOPE_AGENT); }
__device__ __forceinline__ unsigned xb_add(unsigned* p, unsigned v) { return __hip_atomic_fetch_add(p, v, __ATOMIC_RELAXED, __HIP_MEMORY_SCOPE_AGENT); }
__device__ __forceinline__ unsigned xb_xcc_id() { return (unsigned)__builtin_amdgcn_s_getreg((3 << 11) | 20) & 0xFu; }
#define XB_SPIN(cond, bar) do { unsigned _sp = 0; while (cond) { __builtin_amdgcn_s_sleep(1); \
    if ((++_sp & 255u) == 0u) { if (xb_ld(&(bar)[XB_TMO])) break; if (_sp > XB_SPIN_CAP) { atomicAdd(&(bar)[XB_TMO], 1u); break; } } } } while (0)
struct XcdBarrier { unsigned* bar; unsigned x; volatile LAS unsigned* st; };
__device__ __forceinline__ XcdBarrier xcd_barrier_post(unsigned* bar, volatile LAS unsigned* st) {
    XcdBarrier b; b.bar = bar; b.x = xb_xcc_id(); b.st = st;
    if (threadIdx.x == 0) (void)xb_add(&bar[XB_XCNT(b.x)], 1u);
    return b;
}
__device__ __forceinline__ void xcd_barrier_complete(unsigned* bar, unsigned x, unsigned& nloc, unsigned& nx) {
    const unsigned G = gridDim.x * gridDim.y * gridDim.z;
    unsigned sum, cnt, mine, sp = 0u;
    for (;;) {
        sum = 0u; cnt = 0u; mine = 0u;
#pragma unroll
        for (unsigned j = 0; j < 16; ++j) { const unsigned c = xb_ld(&bar[XB_XCNT(j)]); sum += c; cnt += (c > 0u) ? 1u : 0u; mine = (j == x) ? c : mine; }
        if (sum == G) break;
        __builtin_amdgcn_s_sleep(1);
        if ((++sp & 255u) == 0u) { if (xb_ld(&bar[XB_TMO])) break; if (sp > XB_SPIN_CAP) { atomicAdd(&bar[XB_TMO], 1u); break; } }
    }
    nloc = mine > 0u ? mine : 1u; nx = cnt > 0u ? cnt : 1u;
}
__device__ __forceinline__ void xcd_barrier(const XcdBarrier& b) {
    asm volatile("s_waitcnt vmcnt(0)" ::: "memory");
    __syncthreads();
    if (threadIdx.x == 0) {
        unsigned* bar = b.bar;
        __builtin_amdgcn_s_waitcnt(0);
        unsigned nloc = b.st[0], nx = b.st[1];
        if (nloc == 0u) { xcd_barrier_complete(bar, b.x, nloc, nx); b.st[0] = nloc; b.st[1] = nx; }
        const unsigned old = xb_add(&bar[XB_XSUB(b.x)], 1u);
        const unsigned gen = old / nloc;
        if (old + 1u == (gen + 1u) * nloc) {
            __builtin_amdgcn_fence(__ATOMIC_RELEASE, "agent");
            asm volatile("s_waitcnt vmcnt(0)" ::: "memory");
            const unsigned og = xb_add(&bar[XB_TOP], 1u);
            const unsigned tg = og / nx;
            if (og + 1u == (tg + 1u) * nx) xb_add(&bar[XB_TOPGEN], 1u);
            else XB_SPIN(xb_ld(&bar[XB_TOPGEN]) == tg, bar);
            __builtin_amdgcn_fence(__ATOMIC_ACQUIRE, "agent");
            xb_add(&bar[XB_XGEN(b.x)], 1u);
            asm volatile("s_waitcnt vmcnt(0)" ::: "memory");
        } else {
            XB_SPIN(xb_ld(&bar[XB_XGEN(b.x)]) == gen, bar);
            __builtin_amdgcn_fence(__ATOMIC_ACQUIRE, "agent");
            asm volatile("s_waitcnt vmcnt(0)" ::: "memory");
        }
    }
    __syncthreads();
}

namespace pg8 {
#define PG8_LAS __attribute__((address_space(3)))
typedef unsigned short bf16_t;
typedef short bf16x8 __attribute__((ext_vector_type(8)));
typedef float f32x4 __attribute__((ext_vector_type(4)));
typedef unsigned u32x4 __attribute__((ext_vector_type(4)));
constexpr int BM = 256, BK = 64, HALF = 128, HTB = HALF * BK * 2  , STAGE_BYTES = 8 * HTB, NXCD = 8, WGM = 8;

__host__ __device__ __forceinline__ int lds_byte(int r, int c) { const int st = (r >> 4) * 2 + (c >> 5), rr = r & 15, cc = c & 31, ob = rr * 64 + cc * 2; return st * 1024 + (ob ^ (((ob >> 9) & 1) << 5)); }
__host__ __device__ __forceinline__ void stage_rc(int b, int& R, int& C) { const int st = b / 1024, sb = b % 1024, swz = sb ^ (((sb >> 9) & 1) << 5); R = (st >> 1) * 16 + swz / 64; C = (st & 1) * 32 + (swz % 64) / 2; }
__host__ __device__ __forceinline__ int perm32(int rho) { const int n = rho >> 4, i = rho & 15; return 8 * (i >> 2) + 4 * n + (i & 3); }

struct Unit { int pm, pn; };
struct Gemm { const bf16_t* A; const bf16_t* Bt; int M, N, K; };

struct StaticOrder {
    int nM, nN, nwg, G, c;
    __host__ __device__ void init(int M, int N, int G_, int c_) { nM = M / BM; nN = N / BM; nwg = nM * nN; G = G_; c = c_; }
    __host__ __device__ bool next(int i, Unit& u) const {
        const long L = (long)i * G + c; if (L >= nwg) return false;
        int wgid = (int)L; { const int q = nwg / NXCD, r = nwg % NXCD, xcd = wgid % NXCD, off = wgid / NXCD; wgid = (xcd < r ? xcd * (q + 1) : r * (q + 1) + (xcd - r) * q) + off; }
        const int nig = WGM * nN, gid = wgid / nig, fm = gid * WGM, gsz = (nM - fm) < WGM ? (nM - fm) : WGM;
        u.pm = fm + ((wgid % nig) % gsz); u.pn = (wgid % nig) / gsz; return true;
    }
    __device__ __forceinline__ void a_ready(const Unit&) const {}
    __device__ __forceinline__ void done(const Unit&) const {}
};
__device__ __forceinline__ unsigned cvt_pk_bf16(float lo, float hi) { unsigned r; asm volatile("v_cvt_pk_bf16_f32 %0, %1, %2" : "=v"(r) : "v"(lo), "v"(hi)); return r; }
typedef float f32x2 __attribute__((ext_vector_type(2)));
template <class Epi, class Sched, bool ALIGN_EPI = false, bool SP2 = false>
__device__ __forceinline__ void gemm_phase(PG8_LAS unsigned char* lds, const Gemm g, const Sched& S, const Epi& E) {
    const int tid = threadIdx.x, wid = __builtin_amdgcn_readfirstlane(tid >> 6), lane = tid & 63, wr = wid >> 2, wc = wid & 3, fr = lane & 15, fq = lane >> 4;
    const int K = g.K, nt = K / BK;
    unsigned voffA[2], voffB[2];
#pragma unroll
    for (int i = 0; i < 2; ++i) { int R, C; stage_rc(tid * 16 + i * 8192, R, C); const int Rb = Epi::PERM ? ((R & ~31) + perm32(R & 31)) : R;
        voffA[i] = (unsigned)(R * K + C) * 2u; voffB[i] = (unsigned)(Rb * K + C) * 2u; }
    const size_t kstep = (size_t)(BK * 2);
    const size_t hstep = (size_t)HALF * K * 2;
    const size_t tstep = 2 * hstep;
    const unsigned ldsw = (unsigned)wid * 1024u;
    const int aoff = lds_byte(wr * 64 + fr, fq * 8), boff = lds_byte(wc * 32 + fr, fq * 8);
#define PG8_SA(b, h) (((b) * 2 + (h)) * HTB)
#define PG8_SB(b, h) ((4 + (b) * 2 + (h)) * HTB)
#define PG8_STAGE(bufoff, gbase, voff) do { _Pragma("unroll") for (int _i = 0; _i < 2; ++_i) \
        __builtin_amdgcn_global_load_lds((const unsigned*)((const char*)(gbase) + (voff)[_i]), (PG8_LAS unsigned*)(lds + (bufoff) + ldsw + _i * 8192), 16, 0, 0); } while (0)
#define PG8_LDA(dst, b, h) do { _Pragma("unroll") for (int m = 0; m < 4; ++m) _Pragma("unroll") for (int k = 0; k < 2; ++k) dst[m][k] = *(const PG8_LAS bf16x8*)(lds + PG8_SA(b, h) + aoff + m * 2048 + k * 1024); } while (0)
#define PG8_LDB(dst, b, h) do { _Pragma("unroll") for (int n = 0; n < 2; ++n) _Pragma("unroll") for (int k = 0; k < 2; ++k) dst[n][k] = *(const PG8_LAS bf16x8*)(lds + PG8_SB(b, h) + boff + n * 2048 + k * 1024); } while (0)
#define PG8_MMA(ai, bj, At, Bt) do { __builtin_amdgcn_s_setprio(1); _Pragma("unroll") for (int m = 0; m < 4; ++m) _Pragma("unroll") for (int n = 0; n < 2; ++n) _Pragma("unroll") for (int k = 0; k < 2; ++k) \
        acc[ai][bj][m][n] = __builtin_amdgcn_mfma_f32_16x16x32_bf16(Bt[n][k], At[m][k], acc[ai][bj][m][n], 0, 0, 0); __builtin_amdgcn_s_setprio(0); } while (0)
#define PG8_WAIT_V(n) asm volatile("s_waitcnt vmcnt(" #n ")" ::: "memory")
#define PG8_WAIT_L(n) asm volatile("s_waitcnt lgkmcnt(" #n ")" ::: "memory")
#define PG8_BAR __builtin_amdgcn_s_barrier()
#define PG8_SCHED __builtin_amdgcn_sched_barrier(0)
    Unit cur, nxt; int ui = 0;
    if (!S.next(0, cur)) return;
    f32x4 acc[2][2][4][2];
#pragma unroll
    for (int a = 0; a < 2; ++a)
#pragma unroll
        for (int b = 0; b < 2; ++b)
#pragma unroll
            for (int m = 0; m < 4; ++m)
#pragma unroll
                for (int n = 0; n < 2; ++n) acc[a][b][m][n] = (f32x4){0.f, 0.f, 0.f, 0.f};
    bf16x8 At[4][2], B0[2][2], B1[2][2];
    const char* cA = (const char*)g.A + (size_t)cur.pm * tstep; const char* cB = (const char*)g.Bt + (size_t)cur.pn * tstep;
    S.a_ready(cur);
    if constexpr (SP2) {
        PG8_STAGE(PG8_SB(0, 0), cB, voffB); PG8_STAGE(PG8_SB(0, 1), cB + hstep, voffB); PG8_STAGE(PG8_SA(0, 0), cA, voffA); PG8_STAGE(PG8_SA(0, 1), cA + hstep, voffA);
        if (wr == 1) PG8_BAR;
        PG8_WAIT_V(2); PG8_BAR;
        PG8_STAGE(PG8_SB(1, 0), cB + kstep, voffB); PG8_STAGE(PG8_SA(1, 0), cA + kstep, voffA); PG8_STAGE(PG8_SB(1, 1), cB + hstep + kstep, voffB);
        PG8_WAIT_V(6); PG8_BAR;
    } else {
        PG8_STAGE(PG8_SB(0, 0), cB, voffB); PG8_STAGE(PG8_SA(0, 0), cA, voffA); PG8_STAGE(PG8_SB(0, 1), cB + hstep, voffB); PG8_STAGE(PG8_SA(0, 1), cA + hstep, voffA);
        if (wr == 1) PG8_BAR;
        PG8_WAIT_V(4); PG8_BAR;
        PG8_STAGE(PG8_SB(1, 0), cB + kstep, voffB); PG8_STAGE(PG8_SA(1, 0), cA + kstep, voffA); PG8_STAGE(PG8_SB(1, 1), cB + hstep + kstep, voffB);
        PG8_WAIT_V(6); PG8_BAR;
    }
    for (;;) {
        const bool has_next = S.next(ui + 1, nxt);
        const char* nA = has_next ? (const char*)g.A + (size_t)nxt.pm * tstep : cA; const char* nB = has_next ? (const char*)g.Bt + (size_t)nxt.pn * tstep : cB;
        for (int t = 0; t < nt; t += 2) {
            const bool last = (t == nt - 2);
            const char* a1 = cA + (size_t)(t + 1) * kstep;
            const char* a2 = last ? nA : cA + (size_t)(t + 2) * kstep; const char* b2 = last ? nB : cB + (size_t)(t + 2) * kstep;
            const char* a3 = a2 + kstep; const char* b3 = b2 + kstep;
            if (last && has_next) S.a_ready(nxt);
            if constexpr (SP2) {
            PG8_LDB(B0, 0, 0); PG8_LDB(B1, 0, 1); PG8_SCHED; PG8_LDA(At, 0, 0); PG8_STAGE(PG8_SA(1, 1), a1 + hstep, voffA);
            PG8_WAIT_V(8); PG8_WAIT_L(0); PG8_BAR; PG8_MMA(0, 0, At, B0); PG8_MMA(0, 1, At, B1); PG8_BAR; PG8_SCHED;
            PG8_LDA(At, 0, 1); PG8_STAGE(PG8_SB(0, 0), b2, voffB); PG8_STAGE(PG8_SB(0, 1), b2 + hstep, voffB); PG8_STAGE(PG8_SA(0, 0), a2, voffA);
            PG8_WAIT_V(8); PG8_WAIT_L(0); PG8_BAR; PG8_MMA(1, 0, At, B0); PG8_MMA(1, 1, At, B1); PG8_BAR; PG8_SCHED;
            PG8_LDB(B0, 1, 0); PG8_LDB(B1, 1, 1); PG8_SCHED; PG8_LDA(At, 1, 0); PG8_STAGE(PG8_SA(0, 1), a2 + hstep, voffA);
            PG8_WAIT_V(8); PG8_WAIT_L(0); PG8_BAR; PG8_MMA(0, 0, At, B0); PG8_MMA(0, 1, At, B1); PG8_BAR; PG8_SCHED;
            PG8_LDA(At, 1, 1); PG8_STAGE(PG8_SB(1, 0), b3, voffB); PG8_STAGE(PG8_SB(1, 1), b3 + hstep, voffB); PG8_STAGE(PG8_SA(1, 0), a3, voffA);
            PG8_WAIT_V(8); PG8_WAIT_L(0); PG8_BAR; PG8_MMA(1, 0, At, B0); PG8_MMA(1, 1, At, B1); PG8_BAR; PG8_SCHED;
            } else {
            PG8_LDB(B0, 0, 0); PG8_SCHED; PG8_LDA(At, 0, 0); PG8_STAGE(PG8_SA(1, 1), a1 + hstep, voffA);
            PG8_WAIT_L(8); PG8_BAR; PG8_WAIT_L(0); PG8_MMA(0, 0, At, B0); PG8_BAR; PG8_SCHED;
            PG8_LDB(B1, 0, 1); PG8_STAGE(PG8_SB(0, 0), b2, voffB);
            PG8_BAR; PG8_WAIT_L(0); PG8_MMA(0, 1, At, B1); PG8_BAR;
            PG8_LDA(At, 0, 1); PG8_STAGE(PG8_SA(0, 0), a2, voffA);
            PG8_BAR; PG8_WAIT_L(0); PG8_MMA(1, 0, At, B0); PG8_BAR; PG8_SCHED;
            PG8_STAGE(PG8_SB(0, 1), b2 + hstep, voffB);
            PG8_WAIT_V(6); PG8_BAR; PG8_MMA(1, 1, At, B1); PG8_BAR;
            PG8_LDB(B0, 1, 0); PG8_SCHED; PG8_LDA(At, 1, 0); PG8_STAGE(PG8_SA(0, 1), a2 + hstep, voffA);
            PG8_WAIT_L(8); PG8_BAR; PG8_WAIT_L(0); PG8_MMA(0, 0, At, B0); PG8_BAR; PG8_SCHED;
            PG8_LDB(B1, 1, 1); PG8_STAGE(PG8_SB(1, 0), b3, voffB);
            PG8_BAR; PG8_WAIT_L(0); PG8_MMA(0, 1, At, B1); PG8_BAR;
            PG8_LDA(At, 1, 1); PG8_STAGE(PG8_SA(1, 0), a3, voffA);
            PG8_BAR; PG8_WAIT_L(0); PG8_MMA(1, 0, At, B0); PG8_BAR; PG8_SCHED;
            PG8_STAGE(PG8_SB(1, 1), b3 + hstep, voffB);
            PG8_WAIT_V(6); PG8_BAR; PG8_MMA(1, 1, At, B1); PG8_BAR;
            }
        }
        if constexpr (ALIGN_EPI) { if (wr == 0) PG8_BAR; }
        if constexpr (!Epi::AFTER_DRAIN) { E(acc, cur, wr, wc, fr, fq); S.done(cur); }
        if (!has_next) break;
#pragma unroll
        for (int a = 0; a < 2; ++a)
#pragma unroll
            for (int b = 0; b < 2; ++b)
#pragma unroll
                for (int m = 0; m < 4; ++m)
#pragma unroll
                    for (int n = 0; n < 2; ++n) acc[a][b][m][n] = (f32x4){0.f, 0.f, 0.f, 0.f};
        cur = nxt; cA = nA; cB = nB; ++ui;
        if constexpr (ALIGN_EPI) { if (wr == 1) PG8_BAR; }
    }
    PG8_WAIT_V(0);
    if constexpr (!ALIGN_EPI) { if (wr == 0) PG8_BAR; }
    PG8_BAR;
    if constexpr (Epi::AFTER_DRAIN) { E.fused(acc, cur, wr, wc, fr, fq, lds, wid, lane); S.done(cur); }
#undef PG8_SA
#undef PG8_SB
#undef PG8_STAGE
#undef PG8_LDA
#undef PG8_LDB
#undef PG8_MMA
#undef PG8_WAIT_V
#undef PG8_WAIT_L
#undef PG8_BAR
#undef PG8_SCHED
}
}

#define PG8_SP2 true
#define PG8_ALIGN true
using pg8::bf16_t; using pg8::f32x4; using pg8::u32x4;
typedef unsigned u32x2 __attribute__((ext_vector_type(2)));

__device__ __forceinline__ float wave_sum(float v) {
#pragma unroll
    for (int o = 1; o < 64; o <<= 1) v += __shfl_xor(v, o);
    return v;
}
__device__ __forceinline__ float wave_max(float v) {
#pragma unroll
    for (int o = 1; o < 64; o <<= 1) v = fmaxf(v, __shfl_xor(v, o));
    return v;
}
__device__ __forceinline__ float silu_fast(float x) { return x * __builtin_amdgcn_rcpf(1.f + __builtin_amdgcn_exp2f(-1.4426950408889634f * x)); }
__device__ __forceinline__ float logsig_f(float x) { return fminf(x, 0.f) - log1pf(expf(-fabsf(x))); }
__device__ __forceinline__ void rope_cs(int pos, int i, float& c, float& s) {
    const float inv = exp2f(-(float)i * (13.287712379549449f / 32.f));
    double a = (double)pos * (double)inv;
    a -= 6.283185307179586 * floor(a * 0.15915494309189535);
    const float r = (float)a;
    c = cosf(r); s = sinf(r);
}
struct Rows2 { const float* a; const float* b; int split; int ld;
    __device__ __forceinline__ const float* row(int r) const { return r < split ? a + (size_t)r * ld : b + (size_t)(r - split) * ld; } };

__device__ __forceinline__ void rms_rows_1024(const Rows2 src, const float* w, float* dst, int nrows) {
    const int lane = threadIdx.x & 63, gw = blockIdx.x * (NTHR / 64) + (threadIdx.x >> 6), ngw = gridDim.x * (NTHR / 64);
    for (int r = gw; r < nrows; r += ngw) {
        const float4* p = (const float4*)src.row(r) + lane;
        float4 v[4]; float s = 0.f;
#pragma unroll
        for (int j = 0; j < 4; ++j) { v[j] = p[64 * j]; s += v[j].x * v[j].x + v[j].y * v[j].y + v[j].z * v[j].z + v[j].w * v[j].w; }
        const float rstd = 1.0f / sqrtf(wave_sum(s) * (1.f / 1024.f) + EPS);
        float4* o = (float4*)(dst + (size_t)r * DM) + lane;
#pragma unroll
        for (int j = 0; j < 4; ++j) { const float4 ww = ((const float4*)w)[lane + 64 * j]; float4 y; y.x = v[j].x * rstd * ww.x; y.y = v[j].y * rstd * ww.y; y.z = v[j].z * rstd * ww.z; y.w = v[j].w * rstd * ww.w; o[64 * j] = y; }
    }
}

constexpr int RSTAB_OFF = 131072 + 6144;
struct RsTab { int p0, p1, p2, p3; const LAS float* tab; };
__device__ __forceinline__ float rstd_from(const float* ssq, int nslot, int row);
__device__ __forceinline__ float rstab_get(const RsTab& T, const float* slots, int pm, int rit) {
    const int s = pm == T.p0 ? 0 : (pm == T.p1 ? 1 : (pm == T.p2 ? 2 : (pm == T.p3 ? 3 : -1)));
    return s >= 0 ? T.tab[s * 256 + rit] : rstd_from(slots, 16, pm * 256 + rit);
}
__device__ __forceinline__ float rstd_from(const float* ssq, int nslot, int row) {
    float s;
    if (nslot == 1) s = ssq[row];
    else { const f32x4* p = (const f32x4*)(ssq + (size_t)row * 16); const f32x4 a = p[0], b = p[1], c = p[2], d = p[3];
        s = (((a[0] + a[1]) + (a[2] + a[3])) + ((b[0] + b[1]) + (b[2] + b[3]))) + (((c[0] + c[1]) + (c[2] + c[3])) + ((d[0] + d[1]) + (d[2] + d[3]))); }
    return 1.0f / sqrtf(s * (1.f / 1024.f) + EPS);
}
template <bool HAS_RS> struct EpiSwigluB { static constexpr bool PERM = true, AFTER_DRAIN = false;
    bf16_t* H; const float* ssq; int nslot; RsTab T;
    __device__ __forceinline__ void operator()(const f32x4 (&acc)[2][2][4][2], const pg8::Unit& u, int wr, int wc, int fr, int fq) const {
        const int row0 = u.pm * 256 + wr * 64 + fr, col0 = u.pn * 128 + wc * 32 + 8 * fq;
#pragma unroll
        for (int ai = 0; ai < 2; ++ai)
#pragma unroll
            for (int m = 0; m < 4; ++m) { const int row = row0 + ai * 128 + m * 16; const float rs = HAS_RS ? rstab_get(T, ssq, u.pm, wr * 64 + fr + ai * 128 + m * 16) : 1.0f;
                const f32x4 g0 = acc[ai][0][m][0] * rs, g1 = acc[ai][0][m][1] * rs, u0 = acc[ai][1][m][0] * rs, u1 = acc[ai][1][m][1] * rs;
                u32x4 w;
                w.x = pg8::cvt_pk_bf16(silu_fast(g0[0]) * u0[0], silu_fast(g0[1]) * u0[1]); w.y = pg8::cvt_pk_bf16(silu_fast(g0[2]) * u0[2], silu_fast(g0[3]) * u0[3]);
                w.z = pg8::cvt_pk_bf16(silu_fast(g1[0]) * u1[0], silu_fast(g1[1]) * u1[1]); w.w = pg8::cvt_pk_bf16(silu_fast(g1[2]) * u1[2], silu_fast(g1[3]) * u1[3]);
                *(u32x4*)(H + (size_t)row * DFF + col0) = w; }
    }
};
template <bool BASE_BF16> struct EpiResidB { static constexpr bool PERM = true, AFTER_DRAIN = false;
    const float* basef; const bf16_t* baseb; bf16_t* outb; float* slots; float scale;
    __device__ __forceinline__ void operator()(const f32x4 (&acc)[2][2][4][2], const pg8::Unit& u, int wr, int wc, int fr, int fq) const {
        const int row0 = u.pm * 256 + wr * 64 + fr, col0 = u.pn * 256 + wc * 32 + 8 * fq;
#pragma unroll
        for (int ai = 0; ai < 2; ++ai) {
            f32x4 pf[4][2][2]; u32x4 pb[4][2];
#pragma unroll
            for (int m = 0; m < 4; ++m) { const size_t ro = (size_t)(row0 + ai * 128 + m * 16) * DM + col0;
#pragma unroll
                for (int bj = 0; bj < 2; ++bj) { if (BASE_BF16) pb[m][bj] = *(const u32x4*)(baseb + ro + bj * 128); else { pf[m][bj][0] = *(const f32x4*)(basef + ro + bj * 128); pf[m][bj][1] = *(const f32x4*)(basef + ro + bj * 128 + 4); } } }
            __builtin_amdgcn_sched_barrier(0);
#pragma unroll
            for (int m = 0; m < 4; ++m) { const int row = row0 + ai * 128 + m * 16; bf16_t* ob = outb + (size_t)row * DM + col0;
                float ss = 0.f;
#pragma unroll
                for (int bj = 0; bj < 2; ++bj) { f32x4 b0, b1;
                    if (BASE_BF16) { const u32x4 r = pb[m][bj];
                        b0 = (f32x4){__uint_as_float(r.x << 16), __uint_as_float(r.x & 0xffff0000u), __uint_as_float(r.y << 16), __uint_as_float(r.y & 0xffff0000u)};
                        b1 = (f32x4){__uint_as_float(r.z << 16), __uint_as_float(r.z & 0xffff0000u), __uint_as_float(r.w << 16), __uint_as_float(r.w & 0xffff0000u)}; }
                    else { b0 = pf[m][bj][0]; b1 = pf[m][bj][1]; }
                    const f32x4 o0 = b0 + acc[ai][bj][m][0] * scale, o1 = b1 + acc[ai][bj][m][1] * scale;
                    ss += ((o0[0] * o0[0] + o0[1] * o0[1]) + (o0[2] * o0[2] + o0[3] * o0[3])) + ((o1[0] * o1[0] + o1[1] * o1[1]) + (o1[2] * o1[2] + o1[3] * o1[3]));
                    u32x4 w; w.x = pg8::cvt_pk_bf16(o0[0], o0[1]); w.y = pg8::cvt_pk_bf16(o0[2], o0[3]); w.z = pg8::cvt_pk_bf16(o1[0], o1[1]); w.w = pg8::cvt_pk_bf16(o1[2], o1[3]);
                    *(u32x4*)(ob + bj * 128) = w; }
                ss += __shfl_xor(ss, 16); ss += __shfl_xor(ss, 32);
                if (fq == 0) slots[(size_t)row * 16 + u.pn * 4 + wc] = ss; } }
    }
};
struct EpiProj2 { static constexpr bool PERM = false, AFTER_DRAIN = false;
    float* PROJ; const float* slots; RsTab T; bf16_t* CQB; float* CQS; float* CKV; float* KPR; bf16_t* QG; bf16_t* KG; bf16_t* VT; float* VS; bf16_t* SG; float* ALOW;
    __device__ __forceinline__ void operator()(const f32x4 (&acc)[2][2][4][2], const pg8::Unit& u, int wr, int wc, int fr, int fq) const {
        const int row0 = u.pm * 256 + wr * 64 + fr, col0 = u.pn * 256 + wc * 32 + 4 * fq;
#pragma unroll
        for (int ai = 0; ai < 2; ++ai) { if (u.pm == PAD_PM && ai == 1) continue;
#pragma unroll
            for (int m = 0; m < 4; ++m) { const int row = row0 + ai * 128 + m * 16; const float rs = rstab_get(T, slots, u.pm, wr * 64 + fr + ai * 128 + m * 16);
                float ss = 0.f;
#pragma unroll
                for (int bj = 0; bj < 2; ++bj)
#pragma unroll
                    for (int n = 0; n < 2; ++n) { const int c = col0 + bj * 128 + n * 16; const f32x4 v = acc[ai][bj][m][n] * rs;
                        if (u.pn == 0) { u32x2 w; w.x = pg8::cvt_pk_bf16(v[0] * 0.125f, v[1] * 0.125f); w.y = pg8::cvt_pk_bf16(v[2] * 0.125f, v[3] * 0.125f); *(u32x2*)(QG + (size_t)row * 256 + c) = w; }
                        if (u.pn == 1) { u32x2 w; w.x = pg8::cvt_pk_bf16(v[0], v[1]); w.y = pg8::cvt_pk_bf16(v[2], v[3]); *(u32x2*)(KG + (size_t)row * 256 + (c - 256)) = w; }
                        if (u.pn == 4 || u.pn == 5) { u32x2 w; w.x = pg8::cvt_pk_bf16(silu_fast(v[0]), silu_fast(v[1])); w.y = pg8::cvt_pk_bf16(silu_fast(v[2]), silu_fast(v[3])); *(u32x2*)(SG + (size_t)row * 512 + (c - 1024)) = w; }
                        if (u.pn == 6) { u32x2 w; w.x = pg8::cvt_pk_bf16(v[0], v[1]); w.y = pg8::cvt_pk_bf16(v[2], v[3]); *(u32x2*)(CQB + (size_t)row * 256 + (c - 1536)) = w;
                            ss += (v[0] * v[0] + v[1] * v[1]) + (v[2] * v[2] + v[3] * v[3]); }
                        if (u.pn == 7) { const int cc = c - 1792;
                            if (cc < 128) *(f32x4*)(CKV + (size_t)row * 128 + cc) = v;
                            else if (cc < 192) *(f32x4*)(KPR + (size_t)row * 64 + (cc - 128)) = v;
                            else if (cc < 208) *(f32x4*)(ALOW + (size_t)row * 16 + (cc - 192)) = v; } }
                if (u.pn == 6) { ss += __shfl_xor(ss, 16); ss += __shfl_xor(ss, 32); if (fq == 0) CQS[(size_t)row * 4 + wc] = ss; } } }
    }
};
constexpr float QSCALE = 0.07216878364870322f * 1.4426950408889634f;
struct EpiQabs { static constexpr bool PERM = true, AFTER_DRAIN = false;
    bf16_t* QA; const float* CQS; const float2* RT;
    __device__ __forceinline__ void operator()(const f32x4 (&acc)[2][2][4][2], const pg8::Unit& u, int wr, int wc, int fr, int fq) const {
        const int row0 = u.pm * 256 + wr * 64 + fr, colt = wc * 32 + 8 * fq;
#pragma unroll
        for (int ai = 0; ai < 2; ++ai) { if (u.pm == PAD_PM && ai == 1) continue;
#pragma unroll
            for (int m = 0; m < 4; ++m) { const int row = row0 + ai * 128 + m * 16; const f32x4 sl = *(const f32x4*)(CQS + (size_t)row * 4);
                const float rq = QSCALE / sqrtf(((sl[0] + sl[1]) + (sl[2] + sl[3])) * (1.f / 256.f) + EPS);
#pragma unroll
                for (int bj = 0; bj < 2; ++bj) { const f32x4 v0 = acc[ai][bj][m][0] * rq, v1 = acc[ai][bj][m][1] * rq; const int cc = bj * 128 + colt;
                    u32x4 w; w.x = pg8::cvt_pk_bf16(v0[0], v0[1]); w.y = pg8::cvt_pk_bf16(v0[2], v0[3]); w.z = pg8::cvt_pk_bf16(v1[0], v1[1]); w.w = pg8::cvt_pk_bf16(v1[2], v1[3]);
                    *(u32x4*)(QA + (size_t)row * 768 + u.pn * 256 + cc) = w; } } }
    }
};

typedef short bf16x8 __attribute__((ext_vector_type(8)));
typedef float f32x16 __attribute__((ext_vector_type(16)));
typedef short s16x4 __attribute__((ext_vector_type(4)));
typedef float f32x2_t __attribute__((ext_vector_type(2))); typedef __bf16 bf16x2_t __attribute__((ext_vector_type(2)));
__device__ __forceinline__ unsigned cvtpk_s(float lo, float hi) { f32x2_t v = {lo, hi}; bf16x2_t b = __builtin_convertvector(v, bf16x2_t); return __builtin_bit_cast(unsigned, b); }
__device__ __forceinline__ s16x4 vtr(const LAS unsigned char* p) { return __builtin_bit_cast(s16x4, __builtin_amdgcn_ds_read_tr16_b64_v4i16((LAS s16x4*)p)); }
__device__ __forceinline__ int crow(int r, int hi) { return (r & 3) + 8 * (r >> 2) + 4 * hi; }
constexpr int AT_ROWB = 400, AT_BUF = 64 * AT_ROWB;
__device__ __forceinline__ void mla_attn_unit(LAS unsigned char* ldsl, const bf16_t* QA, const bf16_t* KL, const float2* RT, bf16_t* YMIXB, int b, int qb, int tid, int lane, int wave) {
    const int hh = wave >> 1, qs = wave & 1, r32 = lane & 31, hi = lane >> 5;
    const int qpos = qb * 64 + qs * 32 + r32; const size_t qrow = (size_t)b * SEQ + qpos;
    bf16x8 qf[12];
#pragma unroll
    for (int ks = 0; ks < 8; ++ks) qf[ks] = *(const bf16x8*)(QA + qrow * 768 + hh * 128 + 16 * ks + 8 * hi);
#pragma unroll
    for (int ks = 0; ks < 4; ++ks) {
        const u32x4 raw = *(const u32x4*)(QA + qrow * 768 + 512 + hh * 64 + 16 * ks + 8 * hi);
        const f32x4* rp = (const f32x4*)(RT + (size_t)qpos * 32 + 8 * ks + 4 * hi); const f32x4 t0 = rp[0], t1 = rp[1];
        u32x4 w;
        { const float x1 = __uint_as_float(raw.x << 16), x2 = __uint_as_float(raw.x & 0xffff0000u); w.x = cvtpk_s(x1 * t0[0] - x2 * t0[1], x1 * t0[1] + x2 * t0[0]); }
        { const float x1 = __uint_as_float(raw.y << 16), x2 = __uint_as_float(raw.y & 0xffff0000u); w.y = cvtpk_s(x1 * t0[2] - x2 * t0[3], x1 * t0[3] + x2 * t0[2]); }
        { const float x1 = __uint_as_float(raw.z << 16), x2 = __uint_as_float(raw.z & 0xffff0000u); w.z = cvtpk_s(x1 * t1[0] - x2 * t1[1], x1 * t1[1] + x2 * t1[0]); }
        { const float x1 = __uint_as_float(raw.w << 16), x2 = __uint_as_float(raw.w & 0xffff0000u); w.w = cvtpk_s(x1 * t1[2] - x2 * t1[3], x1 * t1[3] + x2 * t1[2]); }
        qf[8 + ks] = __builtin_bit_cast(bf16x8, w); }
    f32x16 o[4];
#pragma unroll
    for (int d = 0; d < 4; ++d)
#pragma unroll
        for (int r = 0; r < 16; ++r) o[d][r] = 0.f;
    float mrun = -1e30f, lrun = 0.f;
    const int nt = qb + 1;
    const unsigned char* kg = (const unsigned char*)(KL + (size_t)b * SEQ * 192);
    u32x4 stg[3];
#pragma unroll
    for (int i = 0; i < 3; ++i) stg[i] = *(const u32x4*)(kg + (size_t)(tid + 512 * i) * 16);
#pragma unroll
    for (int i = 0; i < 3; ++i) { const int c = tid + 512 * i, row = c / 24, col = c - row * 24; *(LAS u32x4*)(ldsl + row * AT_ROWB + col * 16) = stg[i]; }
    __syncthreads();
    const int blk = (lane >> 4) & 1, q4 = (lane & 15) >> 2, p4 = lane & 3;
    const bool gB = wave >= 4;
#define AT_LOADT(tt) _Pragma("unroll") for (int i = 0; i < 3; ++i) stg[i] = *(const u32x4*)(kg + (size_t)(tt) * 24576 + (size_t)(tid + 512 * i) * 16);
#define AT_WRITET(tt) _Pragma("unroll") for (int i = 0; i < 3; ++i) { const int c = tid + 512 * i, row = c / 24, col = c - row * 24; *(LAS u32x4*)(ldsl + ((tt) & 1) * AT_BUF + row * AT_ROWB + col * 16) = stg[i]; }
    if (gB) { if (nt > 1) { AT_LOADT(1) } __syncthreads(); }
    for (int t = 0; t < nt; ++t) {
        const LAS unsigned char* kb = ldsl + (t & 1) * AT_BUF;
        if (!gB && t + 1 < nt) { AT_LOADT(t + 1) }
        f32x16 s0, s1;
#pragma unroll
        for (int r = 0; r < 16; ++r) { s0[r] = 0.f; s1[r] = 0.f; }
#pragma unroll
        for (int ks = 0; ks < 12; ++ks) {
            const bf16x8 k0 = *(const LAS bf16x8*)(kb + r32 * AT_ROWB + 32 * ks + 16 * hi);
            const bf16x8 k1 = *(const LAS bf16x8*)(kb + (32 + r32) * AT_ROWB + 32 * ks + 16 * hi);
            s0 = __builtin_amdgcn_mfma_f32_32x32x16_bf16(k0, qf[ks], s0, 0, 0, 0);
            s1 = __builtin_amdgcn_mfma_f32_32x32x16_bf16(k1, qf[ks], s1, 0, 0, 0);
        }
        if (gB && t + 1 < nt) { AT_WRITET(t + 1) }
        __syncthreads();
        if (gB && t + 2 < nt) { AT_LOADT(t + 2) }
        if (t == qb) {
#pragma unroll
            for (int r = 0; r < 16; ++r) { const int kv = t * 64 + crow(r, hi); if (kv > qpos) s0[r] = -INFINITY; if (kv + 32 > qpos) s1[r] = -INFINITY; }
        }
        float mx = fmaxf(s0[0], s1[0]);
#pragma unroll
        for (int r = 1; r < 16; ++r) mx = fmaxf(mx, fmaxf(s0[r], s1[r]));
        mx = fmaxf(mx, __shfl_xor(mx, 32));
        const float mn = fmaxf(mrun, mx), alpha = __builtin_amdgcn_exp2f(mrun - mn);
        float ps = 0.f;
#pragma unroll
        for (int r = 0; r < 16; ++r) { s0[r] = __builtin_amdgcn_exp2f(s0[r] - mn); s1[r] = __builtin_amdgcn_exp2f(s1[r] - mn); ps += s0[r] + s1[r]; }
        lrun = lrun * alpha + ps; mrun = mn;
        if (__any(alpha != 1.0f)) {
#pragma unroll
            for (int d = 0; d < 4; ++d)
#pragma unroll
                for (int r = 0; r < 16; ++r) o[d][r] *= alpha; }
        bf16x8 pf[4];
#pragma unroll
        for (int s = 0; s < 2; ++s) {
            u32x4 w0, w1;
            w0.x = cvtpk_s(s0[8 * s + 0], s0[8 * s + 1]); w0.y = cvtpk_s(s0[8 * s + 2], s0[8 * s + 3]); w0.z = cvtpk_s(s0[8 * s + 4], s0[8 * s + 5]); w0.w = cvtpk_s(s0[8 * s + 6], s0[8 * s + 7]);
            w1.x = cvtpk_s(s1[8 * s + 0], s1[8 * s + 1]); w1.y = cvtpk_s(s1[8 * s + 2], s1[8 * s + 3]); w1.z = cvtpk_s(s1[8 * s + 4], s1[8 * s + 5]); w1.w = cvtpk_s(s1[8 * s + 6], s1[8 * s + 7]);
            pf[s] = __builtin_bit_cast(bf16x8, w0); pf[2 + s] = __builtin_bit_cast(bf16x8, w1);
        }
#pragma unroll
        for (int kk = 0; kk < 4; ++kk)
#pragma unroll
            for (int d = 0; d < 4; ++d) {
                const int R = 32 * (kk >> 1) + 16 * (kk & 1) + 4 * hi;
                const LAS unsigned char* vp = kb + (R + q4) * AT_ROWB + (32 * d + 16 * blk) * 2 + 8 * p4;
                const s16x4 lo = vtr(vp), hi4 = vtr(vp + 8 * AT_ROWB);
                const bf16x8 vf = (bf16x8){lo[0], lo[1], lo[2], lo[3], hi4[0], hi4[1], hi4[2], hi4[3]};
                o[d] = __builtin_amdgcn_mfma_f32_32x32x16_bf16(vf, pf[kk], o[d], 0, 0, 0);
            }
        if (!gB && t + 1 < nt) { AT_WRITET(t + 1) }
        __syncthreads();
    }
    if (!gB) __syncthreads();
#undef AT_LOADT
#undef AT_WRITET
    const float il = 1.0f / (lrun + __shfl_xor(lrun, 32));
#pragma unroll
    for (int d = 0; d < 4; ++d)
#pragma unroll
        for (int g4 = 0; g4 < 4; ++g4) { u32x2 w; w.x = cvtpk_s(o[d][4 * g4] * il, o[d][4 * g4 + 1] * il); w.y = cvtpk_s(o[d][4 * g4 + 2] * il, o[d][4 * g4 + 3] * il);
            *(u32x2*)(YMIXB + qrow * DM + 512 + hh * 128 + 32 * d + 8 * g4 + 4 * hi) = w; }
}

__device__ __forceinline__ float bf2f(bf16_t x) { return __uint_as_float((unsigned)x << 16); }
constexpr int KTT_PITCH = 144, KTT_BYTES = 64 * KTT_PITCH;
__device__ __forceinline__ void gla_prep_unit(LAS unsigned char* ktt, bf16_t* QG, bf16_t* KG, const float* ALOW, const float* w_a_up, const float* b_a, const bf16_t* VT, float* DEC, bf16_t* UT, int u, int lane) {
    const int c = u & 31, bh = u >> 5, h = bh & 3, b = bh >> 2;
    const size_t row0 = (size_t)b * SEQ + c * 64;
    const int d = lane;
    float wa[16];
#pragma unroll
    for (int r = 0; r < 16; ++r) wa[r] = w_a_up[r * 256 + h * 64 + d];
    const float ba = b_a[h * 64 + d];
    float bsum = 0.f;
#pragma unroll 8
    for (int t = 0; t < 64; ++t) {
        const size_t row = row0 + t;
        const f32x4* ap = (const f32x4*)(ALOW + row * 16); const f32x4 a0 = ap[0], a1 = ap[1], a2 = ap[2], a3 = ap[3];
        float x = ba;
        x += a0[0] * wa[0]; x += a0[1] * wa[1]; x += a0[2] * wa[2]; x += a0[3] * wa[3]; x += a1[0] * wa[4]; x += a1[1] * wa[5]; x += a1[2] * wa[6]; x += a1[3] * wa[7];
        x += a2[0] * wa[8]; x += a2[1] * wa[9]; x += a2[2] * wa[10]; x += a2[3] * wa[11]; x += a3[0] * wa[12]; x += a3[1] * wa[13]; x += a3[2] * wa[14]; x += a3[3] * wa[15];
        const float l2 = (fminf(x, 0.f) * 1.4426950408889634f - __builtin_amdgcn_logf(1.f + __builtin_amdgcn_exp2f(-fabsf(x) * 1.4426950408889634f))) * (1.f / 16.f);
        bsum += l2;
        const float eb = __builtin_amdgcn_exp2f(bsum), enb = __builtin_amdgcn_exp2f(-bsum);
        const size_t off = row * 256 + h * 64 + d;
        const float q = bf2f(QG[off]), k = bf2f(KG[off]);
        const unsigned pk = pg8::cvt_pk_bf16(q * eb, k * enb);
        QG[off] = (bf16_t)(pk & 0xffffu); KG[off] = (bf16_t)(pk >> 16);
        *(LAS bf16_t*)(ktt + d * KTT_PITCH + t * 2) = (bf16_t)(pk >> 16);
    }
    DEC[(size_t)u * 64 + d] = __builtin_amdgcn_exp2f(bsum);
    asm volatile("s_waitcnt lgkmcnt(0)" ::: "memory");
    const int r32 = lane & 31, hi = lane >> 5;
    bf16x8 kf[2][4];
#pragma unroll
    for (int db = 0; db < 2; ++db)
#pragma unroll
        for (int s = 0; s < 4; ++s) kf[db][s] = *(const LAS bf16x8*)(ktt + (32 * db + r32) * KTT_PITCH + (16 * s + 8 * hi) * 2);
    const bf16_t* vt = VT + ((size_t)(bh * 128)) * 2048 + c * 64;
#pragma unroll
    for (int vb = 0; vb < 4; ++vb) {
        bf16x8 vf[4];
#pragma unroll
        for (int s = 0; s < 4; ++s) vf[s] = *(const bf16x8*)(vt + (size_t)(32 * vb + r32) * 2048 + 16 * s + 8 * hi);
#pragma unroll
        for (int db = 0; db < 2; ++db) {
            f32x16 acc;
#pragma unroll
            for (int r = 0; r < 16; ++r) acc[r] = 0.f;
#pragma unroll
            for (int s = 0; s < 4; ++s) acc = __builtin_amdgcn_mfma_f32_32x32x16_bf16(vf[s], kf[db][s], acc, 0, 0, 0);
#pragma unroll
            for (int r = 0; r < 16; ++r) UT[((size_t)u * 128 + 32 * vb + crow(r, hi)) * 64 + 32 * db + r32] = (bf16_t)(cvtpk_s(acc[r], 0.f) & 0xffffu);
        }
    }
    asm volatile("s_waitcnt lgkmcnt(0)" ::: "memory");
}
constexpr int GD_PITCH = 132, GD_BYTES = 32 * GD_PITCH * 4;
__device__ __forceinline__ void gla_out_unit(LAS unsigned char* wl, const bf16_t* QT, const bf16_t* KT, const bf16_t* VT, const bf16_t* ST, const bf16_t* SG, const float* gnw, bf16_t* YMIXB, int u, int lane) {
    const int ib = u & 1, c = (u >> 1) & 31, bh = u >> 6, h = bh & 3, b = bh >> 2;
    const size_t row0 = (size_t)b * SEQ + c * 64;
    const int r32 = lane & 31, hi = lane >> 5;
    const size_t row = row0 + 32 * ib + r32;
    bf16x8 qb[4], sf[4][4], kf[2][4];
#pragma unroll
    for (int s = 0; s < 4; ++s) qb[s] = *(const bf16x8*)(QT + row * 256 + h * 64 + 16 * s + 8 * hi);
    const bf16_t* st = ST + (size_t)(bh * 32 + c) * 128 * 64;
#pragma unroll
    for (int vb = 0; vb < 4; ++vb)
#pragma unroll
        for (int s = 0; s < 4; ++s) sf[vb][s] = *(const bf16x8*)(st + (size_t)(32 * vb + r32) * 64 + 16 * s + 8 * hi);
#pragma unroll
    for (int jb = 0; jb < 2; ++jb)
#pragma unroll
        for (int s = 0; s < 4; ++s) kf[jb][s] = *(const bf16x8*)(KT + (row0 + 32 * (jb <= ib ? jb : 0) + r32) * 256 + h * 64 + 16 * s + 8 * hi);
    __builtin_amdgcn_sched_barrier(0);
    f32x16 o[4];
#pragma unroll
    for (int vb = 0; vb < 4; ++vb) {
#pragma unroll
        for (int r = 0; r < 16; ++r) o[vb][r] = 0.f;
#pragma unroll
        for (int s = 0; s < 4; ++s) o[vb] = __builtin_amdgcn_mfma_f32_32x32x16_bf16(sf[vb][s], qb[s], o[vb], 0, 0, 0); }
    const bf16_t* vt = VT + ((size_t)(bh * 128)) * 2048 + c * 64;
    u32x4 vv[2][2][4];
#pragma unroll
    for (int jb = 0; jb < 2; ++jb)
#pragma unroll
        for (int s2 = 0; s2 < 2; ++s2)
#pragma unroll
            for (int vb = 0; vb < 4; ++vb) { const bf16_t* vp = vt + (size_t)(32 * vb + r32) * 2048 + 32 * (jb <= ib ? jb : 0) + 16 * s2 + 8 * hi;
                const u32x4 raw = *(const u32x4*)vp;
                const auto s0_ = __builtin_amdgcn_permlane32_swap(raw.x, raw.z, false, false); const auto s1_ = __builtin_amdgcn_permlane32_swap(raw.y, raw.w, false, false);
                vv[jb][s2][vb] = (u32x4){s0_[0], s1_[0], s0_[1], s1_[1]}; }
    __builtin_amdgcn_sched_barrier(0);
#pragma unroll
    for (int jb = 0; jb < 2; ++jb) {
        if (jb <= ib) {
            f32x16 x;
#pragma unroll
            for (int r = 0; r < 16; ++r) x[r] = 0.f;
#pragma unroll
            for (int s = 0; s < 4; ++s) x = __builtin_amdgcn_mfma_f32_32x32x16_bf16(kf[jb][s], qb[s], x, 0, 0, 0);
            if (jb == ib) {
#pragma unroll
                for (int r = 0; r < 16; ++r) if (crow(r, hi) > r32) x[r] = 0.f; }
#pragma unroll
            for (int s2 = 0; s2 < 2; ++s2) {
                u32x4 w; w.x = cvtpk_s(x[8 * s2 + 0], x[8 * s2 + 1]); w.y = cvtpk_s(x[8 * s2 + 2], x[8 * s2 + 3]); w.z = cvtpk_s(x[8 * s2 + 4], x[8 * s2 + 5]); w.w = cvtpk_s(x[8 * s2 + 6], x[8 * s2 + 7]);
                const bf16x8 pf = __builtin_bit_cast(bf16x8, w);
#pragma unroll
                for (int vb = 0; vb < 4; ++vb) o[vb] = __builtin_amdgcn_mfma_f32_32x32x16_bf16(__builtin_bit_cast(bf16x8, vv[jb][s2][vb]), pf, o[vb], 0, 0, 0);
            }
        }
    }
    float ss = 0.f;
#pragma unroll
    for (int vb = 0; vb < 4; ++vb)
#pragma unroll
        for (int r = 0; r < 16; ++r) ss += o[vb][r] * o[vb][r];
    ss += __shfl_xor(ss, 32);
    u32x4 sgp[8];
#pragma unroll
    for (int k = 0; k < 8; ++k) { const int p = lane + 64 * k; sgp[k] = *(const u32x4*)(SG + (row0 + 32 * ib + (p >> 4)) * 512 + h * 128 + 8 * (p & 15)); }
    const float rstd = 1.0f / sqrtf(ss * (1.f / 128.f) + EPS);
    LAS float* tl = (LAS float*)wl;
#pragma unroll
    for (int vb = 0; vb < 4; ++vb)
#pragma unroll
        for (int g4 = 0; g4 < 4; ++g4) *(LAS f32x4*)(tl + r32 * GD_PITCH + 32 * vb + 8 * g4 + 4 * hi) = (f32x4){o[vb][4 * g4 + 0] * rstd, o[vb][4 * g4 + 1] * rstd, o[vb][4 * g4 + 2] * rstd, o[vb][4 * g4 + 3] * rstd};
    asm volatile("s_waitcnt lgkmcnt(0)" ::: "memory");
#pragma unroll
    for (int k = 0; k < 8; ++k) { const int p = lane + 64 * k, tok = p >> 4, v8 = 8 * (p & 15);
        const f32x4 a = *(const LAS f32x4*)(tl + tok * GD_PITCH + v8), b2 = *(const LAS f32x4*)(tl + tok * GD_PITCH + v8 + 4);
        const f32x4 g0 = *(const f32x4*)(gnw + v8), g1 = *(const f32x4*)(gnw + v8 + 4); const u32x4 sgv = sgp[k];
        u32x4 w;
        w.x = cvtpk_s(a[0] * g0[0] * __uint_as_float(sgv.x << 16), a[1] * g0[1] * __uint_as_float(sgv.x & 0xffff0000u));
        w.y = cvtpk_s(a[2] * g0[2] * __uint_as_float(sgv.y << 16), a[3] * g0[3] * __uint_as_float(sgv.y & 0xffff0000u));
        w.z = cvtpk_s(b2[0] * g1[0] * __uint_as_float(sgv.z << 16), b2[1] * g1[1] * __uint_as_float(sgv.z & 0xffff0000u));
        w.w = cvtpk_s(b2[2] * g1[2] * __uint_as_float(sgv.w << 16), b2[3] * g1[3] * __uint_as_float(sgv.w & 0xffff0000u));
        *(u32x4*)(YMIXB + (row0 + 32 * ib + tok) * DM + h * 128 + v8) = w; }
    asm volatile("s_waitcnt lgkmcnt(0)" ::: "memory");
}

constexpr int DQ_BYTES = 32 * AT_ROWB;
__device__ __forceinline__ void decode_item_mfma(LAS unsigned char* ldsl, const bf16_t* QA, const float2* RT, const float* cache_kv, const float* cache_pe, const int* page_table, float* PART, int item, int tid, int lane, int wave) {
    const int bs = item >> 1, half = item & 1, r32 = lane & 31, hi = lane >> 5;
    const size_t qrow = (size_t)(MP + bs);
    __syncthreads();
#pragma unroll 1
    for (int e = 100 + tid; e < 32 * AT_ROWB / 16; e += 512) *(LAS u32x4*)(ldsl + e * 16) = (u32x4){0u, 0u, 0u, 0u};
#pragma unroll 1
    for (int e = tid; e < 768; e += 512) { const int row = e >= 576 ? 3 : (e >= 384 ? 2 : (e >= 192 ? 1 : 0)), col = e - 192 * row; float v;
        if (col < 128) v = bf2f(QA[qrow * 768 + row * 128 + col]);
        else { const int n = col - 128, ii = n & 31; const unsigned pr = *(const unsigned*)(QA + qrow * 768 + 512 + row * 64 + 2 * ii);
            const float x1 = __uint_as_float(pr << 16), x2 = __uint_as_float(pr & 0xffff0000u); const float2 cs = RT[(size_t)SEQ * 32 + ii]; v = n < 32 ? x1 * cs.x - x2 * cs.y : x1 * cs.y + x2 * cs.x; }
        *(LAS bf16_t*)(ldsl + row * AT_ROWB + col * 2) = (bf16_t)(cvtpk_s(v, 0.f) & 0xffffu); }
    if (tid < 4) { *(LAS u32x4*)(ldsl + tid * AT_ROWB + 384) = (u32x4){0u, 0u, 0u, 0u}; }
    __syncthreads();
    LAS unsigned char* kt = ldsl + (1 + wave) * DQ_BYTES;
    const int ptv = page_table[bs * NPAGES + half * 32 + r32];
    f32x16 o[4];
#pragma unroll
    for (int d = 0; d < 4; ++d)
#pragma unroll
        for (int r = 0; r < 16; ++r) o[d][r] = 0.f;
    float mrun = -1e30f, lrun = 0.f;
    const int blk = (lane >> 4) & 1, q4 = (lane & 15) >> 2, p4 = lane & 3;
    f32x4 sl[16], sp[8];
    const __amdgpu_buffer_rsrc_t rkv = __builtin_amdgcn_make_buffer_rsrc((void*)cache_kv, 0, 0x7fffffff, 0x00020000);
    const __amdgpu_buffer_rsrc_t rpe = __builtin_amdgcn_make_buffer_rsrc((void*)cache_pe, 0, 0x7fffffff, 0x00020000);
    const int lo16 = lane * 16;
#define DM_LOAD(kbi) { const int j0_ = 32 * (kbi); const int pg_ = __builtin_amdgcn_readlane(ptv, j0_ >> 7); const int r0_ = pg_ * PAGE + (j0_ & 127); \
        _Pragma("unroll") for (int c_ = 0; c_ < 16; ++c_) sl[c_] = __builtin_bit_cast(f32x4, __builtin_amdgcn_raw_buffer_load_b128(rkv, lo16, r0_ * 512 + 1024 * c_, 2)); \
        _Pragma("unroll") for (int c_ = 0; c_ < 8; ++c_) sp[c_] = __builtin_bit_cast(f32x4, __builtin_amdgcn_raw_buffer_load_b128(rpe, lo16, r0_ * 256 + 1024 * c_, 2)); }
    DM_LOAD(wave)
    for (int i = 0; i < 16; ++i) {
#pragma unroll
        for (int c = 0; c < 16; ++c) { const int ch = lane + 64 * c, row = ch >> 5, col4 = ch & 31; u32x2 w; w.x = cvtpk_s(sl[c][0], sl[c][1]); w.y = cvtpk_s(sl[c][2], sl[c][3]); *(LAS u32x2*)(kt + row * AT_ROWB + col4 * 8) = w; }
#pragma unroll
        for (int c = 0; c < 8; ++c) { const int ch = lane + 64 * c, row = ch >> 4, col4 = ch & 15; u32x2 w; w.x = cvtpk_s(sp[c][0], sp[c][1]); w.y = cvtpk_s(sp[c][2], sp[c][3]); *(LAS u32x2*)(kt + row * AT_ROWB + 256 + col4 * 8) = w; }
        { const int in_ = i + 1 < 16 ? i + 1 : 15; DM_LOAD(wave + 8 * in_) }
        f32x16 s;
#pragma unroll
        for (int r = 0; r < 16; ++r) s[r] = 0.f;
#pragma unroll
        for (int ks = 0; ks < 12; ++ks) { const bf16x8 kf = *(const LAS bf16x8*)(kt + r32 * AT_ROWB + 32 * ks + 16 * hi); const bf16x8 qfr = *(const LAS bf16x8*)(ldsl + r32 * AT_ROWB + 32 * ks + 16 * hi);
            s = __builtin_amdgcn_mfma_f32_32x32x16_bf16(kf, qfr, s, 0, 0, 0); }
        float mx = s[0];
#pragma unroll
        for (int r = 1; r < 16; ++r) mx = fmaxf(mx, s[r]);
        mx = fmaxf(mx, __shfl_xor(mx, 32));
        const float mn = fmaxf(mrun, mx), alpha = __builtin_amdgcn_exp2f(mrun - mn);
        float ps = 0.f;
#pragma unroll
        for (int r = 0; r < 16; ++r) { s[r] = __builtin_amdgcn_exp2f(s[r] - mn); ps += s[r]; }
        lrun = lrun * alpha + ps; mrun = mn;
        if (__any(alpha != 1.0f)) {
#pragma unroll
            for (int d = 0; d < 4; ++d)
#pragma unroll
                for (int r = 0; r < 16; ++r) o[d][r] *= alpha; }
        bf16x8 pf[2];
#pragma unroll
        for (int s2 = 0; s2 < 2; ++s2) { u32x4 w; w.x = cvtpk_s(s[8 * s2 + 0], s[8 * s2 + 1]); w.y = cvtpk_s(s[8 * s2 + 2], s[8 * s2 + 3]); w.z = cvtpk_s(s[8 * s2 + 4], s[8 * s2 + 5]); w.w = cvtpk_s(s[8 * s2 + 6], s[8 * s2 + 7]); pf[s2] = __builtin_bit_cast(bf16x8, w); }
#pragma unroll
        for (int d = 0; d < 4; ++d)
#pragma unroll
            for (int s2 = 0; s2 < 2; ++s2) { const int R = 16 * s2 + 4 * hi; const LAS unsigned char* vp = kt + (R + q4) * AT_ROWB + (32 * d + 16 * blk) * 2 + 8 * p4;
                const s16x4 lo = vtr(vp), hi4 = vtr(vp + 8 * AT_ROWB); const bf16x8 vf = (bf16x8){lo[0], lo[1], lo[2], lo[3], hi4[0], hi4[1], hi4[2], hi4[3]};
                o[d] = __builtin_amdgcn_mfma_f32_32x32x16_bf16(vf, pf[s2], o[d], 0, 0, 0); }
    }
#undef DM_LOAD
    const float ltot = lrun + __shfl_xor(lrun, 32);
    asm volatile("s_waitcnt vmcnt(0) lgkmcnt(0)" ::: "memory");
    LAS float* sw = (LAS float*)kt;
    if (r32 < 4) {
#pragma unroll
        for (int d = 0; d < 4; ++d)
#pragma unroll
            for (int r = 0; r < 16; ++r) sw[r32 * 130 + 32 * d + crow(r, hi)] = o[d][r];
        if (hi == 0) { sw[r32 * 130 + 128] = mrun; sw[r32 * 130 + 129] = ltot; } }
    __syncthreads();
    {   const int h = tid >> 7, dim = tid & 127; float M = -1e30f;
#pragma unroll
        for (int w = 0; w < 8; ++w) M = fmaxf(M, ((const LAS float*)(ldsl + (1 + w) * DQ_BYTES))[h * 130 + 128]);
        float L = 0.f, O = 0.f;
#pragma unroll
        for (int w = 0; w < 8; ++w) { const LAS float* pw = (const LAS float*)(ldsl + (1 + w) * DQ_BYTES) + h * 130; const float f = __builtin_amdgcn_exp2f(pw[128] - M); L += pw[129] * f; O += pw[dim] * f; }
        float* pp = PART + (size_t)(item * 4 + h) * 132; pp[dim] = O; if (dim == 0) { pp[128] = M; pp[129] = L; } }
    __syncthreads();
}

template <int NB>
__device__ __forceinline__ void skinny_tile(LAS unsigned char* ldsl, const bf16_t* A, int lda, const bf16_t* B0, const bf16_t* B1, int K, int lane, int wave, f32x4 (&acc)[NB], float& ssq) {
    const int r16 = lane & 15, kq = lane >> 4; int kw = K >> 3; asm volatile("" : "+s"(kw));
    f32x4 pa[NB][8]; float ps[8];
#pragma unroll
    for (int g = 0; g < 8; ++g) { ps[g] = 0.f;
#pragma unroll
        for (int n = 0; n < NB; ++n) pa[n][g] = (f32x4){0.f, 0.f, 0.f, 0.f}; }
    const bf16_t* ap = A + (size_t)r16 * lda + wave * kw + 8 * kq;
    const bf16_t* bp0 = B0 + (size_t)r16 * K + wave * kw + 8 * kq; const bf16_t* bp1 = B1 + (size_t)r16 * K + wave * kw + 8 * kq;
    if (NB == 1) {
#pragma unroll 4
    for (int k0 = 0; k0 < kw; k0 += 32) {
        const bf16x8 b0 = *(const bf16x8*)(bp0 + k0); bf16x8 b1 = b0; if (NB == 2) b1 = *(const bf16x8*)(bp1 + k0);
#pragma unroll
        for (int g = 0; g < 8; ++g) { const u32x4 a = *(const u32x4*)(ap + (size_t)(16 * g) * lda + k0);
            pa[0][g] = __builtin_amdgcn_mfma_f32_16x16x32_bf16(__builtin_bit_cast(bf16x8, a), b0, pa[0][g], 0, 0, 0);
            if (NB == 2) pa[NB - 1][g] = __builtin_amdgcn_mfma_f32_16x16x32_bf16(__builtin_bit_cast(bf16x8, a), b1, pa[NB - 1][g], 0, 0, 0);
            const float a0 = __uint_as_float(a.x << 16), a1 = __uint_as_float(a.x & 0xffff0000u), a2 = __uint_as_float(a.y << 16), a3 = __uint_as_float(a.y & 0xffff0000u);
            const float a4 = __uint_as_float(a.z << 16), a5 = __uint_as_float(a.z & 0xffff0000u), a6 = __uint_as_float(a.w << 16), a7 = __uint_as_float(a.w & 0xffff0000u);
            ps[g] += (a0 * a0 + a1 * a1) + (a2 * a2 + a3 * a3) + (a4 * a4 + a5 * a5) + (a6 * a6 + a7 * a7); }
    }
    } else {
#pragma unroll 2
    for (int k0 = 0; k0 < kw; k0 += 32) {
        const bf16x8 b0 = *(const bf16x8*)(bp0 + k0); bf16x8 b1 = b0; if (NB == 2) b1 = *(const bf16x8*)(bp1 + k0);
#pragma unroll
        for (int g = 0; g < 8; ++g) { const u32x4 a = *(const u32x4*)(ap + (size_t)(16 * g) * lda + k0);
            pa[0][g] = __builtin_amdgcn_mfma_f32_16x16x32_bf16(__builtin_bit_cast(bf16x8, a), b0, pa[0][g], 0, 0, 0);
            if (NB == 2) pa[NB - 1][g] = __builtin_amdgcn_mfma_f32_16x16x32_bf16(__builtin_bit_cast(bf16x8, a), b1, pa[NB - 1][g], 0, 0, 0);
            const float a0 = __uint_as_float(a.x << 16), a1 = __uint_as_float(a.x & 0xffff0000u), a2 = __uint_as_float(a.y << 16), a3 = __uint_as_float(a.y & 0xffff0000u);
            const float a4 = __uint_as_float(a.z << 16), a5 = __uint_as_float(a.z & 0xffff0000u), a6 = __uint_as_float(a.w << 16), a7 = __uint_as_float(a.w & 0xffff0000u);
            ps[g] += (a0 * a0 + a1 * a1) + (a2 * a2 + a3 * a3) + (a4 * a4 + a5 * a5) + (a6 * a6 + a7 * a7); }
    }
    }
    LAS f32x4* red = (LAS f32x4*)ldsl; LAS float* rs = (LAS float*)(ldsl + 131072 + 1024);
#pragma unroll
    for (int g = 0; g < 8; ++g) {
#pragma unroll
        for (int n = 0; n < NB; ++n) red[((wave * NB + n) * 8 + g) * 64 + lane] = pa[n][g];
        float s = ps[g]; s += __shfl_xor(s, 16); s += __shfl_xor(s, 32); if (kq == 0) rs[(wave * 8 + g) * 16 + r16] = s; }
    __syncthreads();
#pragma unroll
    for (int n = 0; n < NB; ++n) { f32x4 s = red[((0 * NB + n) * 8 + wave) * 64 + lane];
#pragma unroll
        for (int w = 1; w < 8; ++w) s += red[((w * NB + n) * 8 + wave) * 64 + lane];
        acc[n] = s; }
    { float s = 0.f;
#pragma unroll
      for (int w = 0; w < 8; ++w) s += rs[(w * 8 + wave) * 16 + r16];
      ssq = s; }
    __syncthreads();
}
__device__ __forceinline__ bf16_t f2bf1(float v) { return (bf16_t)(pg8::cvt_pk_bf16(v, 0.f) & 0xffffu); }
template <bool HAS_RS> __device__ __forceinline__ void sk_swiglu(LAS unsigned char* ldsl, const bf16_t* XBs, const bf16_t* WGU, bf16_t* Hs, int lane, int wave) {
    for (int t = blockIdx.x; t < DFF / 16; t += gridDim.x) {
        const int n0 = 256 * (t >> 3) + 16 * (t & 7); f32x4 acc[2]; float ssq;
        skinny_tile<2>(ldsl, XBs, DM, WGU + (size_t)n0 * DM, WGU + (size_t)(n0 + 128) * DM, DM, lane, wave, acc, ssq);
#pragma unroll
        for (int i = 0; i < 4; ++i) { const int rl = 4 * (lane >> 4) + i; const float rs = HAS_RS ? 1.0f / sqrtf(__shfl(ssq, rl) * (1.f / 1024.f) + EPS) : 1.0f;
            Hs[(size_t)(16 * wave + rl) * DFF + 16 * t + (lane & 15)] = f2bf1(silu_fast(acc[0][i] * rs) * (acc[1][i] * rs)); }
    }
}
__device__ __forceinline__ void sk_resid(LAS unsigned char* ldsl, const bf16_t* As, int K, const bf16_t* Wt, const float* bases, float* Xs, bf16_t* XBs, float scale, int lane, int wave) {
    for (int t = blockIdx.x; t < DM / 16; t += gridDim.x) {
        f32x4 acc[1]; float ssq;
        skinny_tile<1>(ldsl, As, K, Wt + (size_t)(16 * t) * K, Wt, K, lane, wave, acc, ssq);
#pragma unroll
        for (int i = 0; i < 4; ++i) { const size_t o = (size_t)(16 * wave + 4 * (lane >> 4) + i) * DM + 16 * t + (lane & 15); const float v = bases[o] + scale * acc[0][i]; Xs[o] = v; XBs[o] = f2bf1(v); }
    }
}
__device__ __forceinline__ void sk_proj(LAS unsigned char* ldsl, const bf16_t* X1Bs, const bf16_t* WINt, bf16_t* QGs, bf16_t* KGs, float* VSs, bf16_t* SGs, bf16_t* CQBs, float* CKVs, float* KPRs, float* ALOWs, int lane, int wave) {
    for (int t = blockIdx.x; t < 125; t += gridDim.x) {
        f32x4 acc[1]; float ssq;
        skinny_tile<1>(ldsl, X1Bs, DM, WINt + (size_t)(16 * t) * DM, WINt, DM, lane, wave, acc, ssq);
        const int c = 16 * t + (lane & 15);
#pragma unroll
        for (int i = 0; i < 4; ++i) { const int rl = 4 * (lane >> 4) + i; const size_t r = (size_t)(16 * wave + rl); const float v = acc[0][i] / sqrtf(__shfl(ssq, rl) * (1.f / 1024.f) + EPS);
            if (t < 16) QGs[r * 256 + c] = f2bf1(v * 0.125f);
            else if (t < 32) KGs[r * 256 + (c - 256)] = f2bf1(v);
            else if (t < 64) VSs[r * 512 + (c - 512)] = v;
            else if (t < 96) SGs[r * 512 + (c - 1024)] = f2bf1(silu_fast(v));
            else if (t < 112) CQBs[r * 256 + (c - 1536)] = f2bf1(v);
            else if (t < 120) CKVs[r * 128 + (c - 1792)] = v;
            else if (t < 124) KPRs[r * 64 + (c - 1920)] = v;
            else ALOWs[r * 16 + (c - 1984)] = v; }
    }
}
__device__ __forceinline__ void sk_qabs(LAS unsigned char* ldsl, const bf16_t* CQBs, const bf16_t* WQAt, bf16_t* QAs, int lane, int wave) {
    for (int t = blockIdx.x; t < 48; t += gridDim.x) {
        f32x4 acc[1]; float ssq;
        skinny_tile<1>(ldsl, CQBs, 256, WQAt + (size_t)(16 * t) * 256, WQAt, 256, lane, wave, acc, ssq);
#pragma unroll
        for (int i = 0; i < 4; ++i) { const int rl = 4 * (lane >> 4) + i; const float rq = QSCALE / sqrtf(__shfl(ssq, rl) * (1.f / 256.f) + EPS);
            QAs[(size_t)(16 * wave + rl) * 768 + 16 * t + (lane & 15)] = f2bf1(acc[0][i] * rq); }
    }
}

struct MapId { __device__ __forceinline__ int operator()(int n) const { return n; } };
struct MapGU { int off; __device__ __forceinline__ int operator()(int n) const { return 256 * (n >> 7) + (n & 127) + off; } };
struct MapWin { __device__ __forceinline__ int operator()(int n) const { return n < 1536 ? n : (n < 1552 ? n + 448 : n - 16); } };
template <class Map>
__device__ __forceinline__ void tr_item(const float* W, int K, int N, const float* kscale, bf16_t* WT, const Map map, LAS float* scr, int item, int lane, int ldk = 0) {
    if (ldk == 0) ldk = K;
    const int nblk = (N + 63) / 64, kb = item / nblk, nb = item - kb * nblk, k0 = 64 * kb, n0 = 64 * nb;
    const int c4 = lane & 15, kr = lane >> 4, nn = n0 + 4 * c4;
    f32x4 v[16];
#pragma unroll
    for (int i = 0; i < 16; ++i) { v[i] = (f32x4){0.f, 0.f, 0.f, 0.f}; if (nn < N) v[i] = *(const f32x4*)(W + (size_t)(k0 + kr + 4 * i) * N + nn); }
#pragma unroll
    for (int i = 0; i < 16; ++i) { const int kk = kr + 4 * i; const float s = kscale ? kscale[k0 + kk] : 1.0f; LAS float* d = scr + kk * 65 + 4 * c4; d[0] = v[i][0] * s; d[1] = v[i][1] * s; d[2] = v[i][2] * s; d[3] = v[i][3] * s; }
    asm volatile("s_waitcnt lgkmcnt(0)" ::: "memory");
    const int c = lane & 7;
#pragma unroll
    for (int j = 0; j < 8; ++j) { const int n = (lane >> 3) + 8 * j; const LAS float* s = scr + (8 * c) * 65 + n;
        u32x4 o; o.x = pg8::cvt_pk_bf16(s[0 * 65], s[1 * 65]); o.y = pg8::cvt_pk_bf16(s[2 * 65], s[3 * 65]); o.z = pg8::cvt_pk_bf16(s[4 * 65], s[5 * 65]); o.w = pg8::cvt_pk_bf16(s[6 * 65], s[7 * 65]);
        if (n0 + n < N) *(u32x4*)(WT + (size_t)map(n0 + n) * ldk + k0 + 8 * c) = o; }
    asm volatile("s_waitcnt lgkmcnt(0)" ::: "memory");
}

struct EpiVT { static constexpr bool PERM = true, AFTER_DRAIN = false;
    bf16_t* VT; const LAS float* tab;
    __device__ __forceinline__ void operator()(const f32x4 (&acc)[2][2][4][2], const pg8::Unit& u, int wr, int wc, int fr, int fq) const {
        const int tok0 = u.pn * 256 + wc * 32 + 8 * fq, bb = tok0 >> 11, t0 = tok0 & 2047;
        f32x4 rs[2][2];
#pragma unroll
        for (int bj = 0; bj < 2; ++bj)
#pragma unroll
            for (int n = 0; n < 2; ++n) rs[bj][n] = *(const LAS f32x4*)(tab + bj * 128 + wc * 32 + 8 * fq + 4 * n);
#pragma unroll
        for (int ai = 0; ai < 2; ++ai)
#pragma unroll
            for (int m = 0; m < 4; ++m) { const int cv = u.pm * 256 + ai * 128 + wr * 64 + m * 16 + fr;
                bf16_t* p = VT + ((size_t)((bb * 4 + (cv >> 7)) * 128 + (cv & 127))) * 2048 + t0;
#pragma unroll
                for (int bj = 0; bj < 2; ++bj) { const f32x4 o0 = acc[ai][bj][m][0] * rs[bj][0], o1 = acc[ai][bj][m][1] * rs[bj][1];
                    u32x4 w; w.x = pg8::cvt_pk_bf16(o0[0], o0[1]); w.y = pg8::cvt_pk_bf16(o0[2], o0[3]); w.z = pg8::cvt_pk_bf16(o1[0], o1[1]); w.w = pg8::cvt_pk_bf16(o1[2], o1[3]);
                    *(u32x4*)(p + bj * 128) = w; } }
    }
};
struct OneUnit { pg8::Unit u0;
    __device__ __forceinline__ bool next(int i, pg8::Unit& u) const { if (i != 0) return false; u = u0; return true; }
    __device__ __forceinline__ void a_ready(const pg8::Unit&) const {}
    __device__ __forceinline__ void done(const pg8::Unit&) const {}
};
struct SkipVOrder { pg8::StaticOrder S;
    __host__ __device__ void init(int M, int N, int G_, int c_) { S.init(M, N, G_, c_); }
    __host__ __device__ bool next(int i, pg8::Unit& u) const { if (!S.next(i, u)) return false; u.pn += u.pn >= 2 ? 2 : 0; return true; }
    __device__ __forceinline__ void a_ready(const pg8::Unit&) const {}
    __device__ __forceinline__ void done(const pg8::Unit&) const {}
};
template <class Sched> __device__ __forceinline__ RsTab build_rstab(LAS unsigned char* ldsl_, const Sched& S, const float* slots, int tid_) {
    RsTab T; T.p0 = T.p1 = T.p2 = T.p3 = -1; T.tab = (const LAS float*)(ldsl_ + RSTAB_OFF); int n = 0; pg8::Unit u;
    for (int i = 0; S.next(i, u); ++i) { if (u.pm != T.p0 && u.pm != T.p1 && u.pm != T.p2 && u.pm != T.p3) { if (n == 0) T.p0 = u.pm; else if (n == 1) T.p1 = u.pm; else if (n == 2) T.p2 = u.pm; else if (n == 3) T.p3 = u.pm; ++n; } }
    LAS float* tab = (LAS float*)(ldsl_ + RSTAB_OFF);
    const int rit = tid_ & 255, s0 = tid_ >> 8;
#pragma unroll
    for (int k = 0; k < 2; ++k) { const int s = s0 + 2 * k; const int pm = s == 0 ? T.p0 : (s == 1 ? T.p1 : (s == 2 ? T.p2 : T.p3)); if (pm >= 0) tab[s * 256 + rit] = rstd_from(slots, 16, pm * 256 + rit); }
    __syncthreads();
    return T;
}

struct Args { const void* in[26]; float* out; unsigned char* ws; int ph_lo, ph_hi, one, pad; };
constexpr int NPHASE = 11;

__global__ void __launch_bounds__(NTHR, 2) fwd_kernel(Args args) {
    extern __shared__ __attribute__((aligned(16))) unsigned char lds_raw[];
#define lds ((float*)lds_raw)
#define ldsl ((LAS unsigned char*)lds_raw)
#define MISC ((volatile LAS unsigned*)(ldsl + MISC_OFF))
#define tid ((int)threadIdx.x)
#define lane ((int)(threadIdx.x & 63u))
#define wave ((int)__builtin_amdgcn_readfirstlane((int)(threadIdx.x >> 6)))
#define gtid ((int)(blockIdx.x * NTHR + threadIdx.x))
#define gthr ((int)(gridDim.x * NTHR))
#define gw ((int)(blockIdx.x * (NTHR / 64)) + wave)
#define ngw ((int)(gridDim.x * (NTHR / 64)))
    if (tid < 32) MISC[tid] = 0u;
    __syncthreads();
    XcdBarrier bar; bar.bar = (unsigned*)args.ws + 4096; bar.x = 0; bar.st = nullptr;
    if (args.one) bar = xcd_barrier_post((unsigned*)args.ws + 4096, MISC + 8);

    float* out = args.out;
    unsigned char* ws = args.ws;
#define x_p ((const float*)((const float*)args.in[0]))
#define x_s ((const float*)((const float*)args.in[1]))
#define cache_kv ((const float*)((const float*)args.in[2]))
#define cache_pe ((const float*)((const float*)args.in[3]))
#define state_gla ((const float*)((const float*)args.in[4]))
#define page_table ((const int*)((const int*)args.in[5]))
#define f1n ((const float*)((const float*)args.in[6]))
#define f1g ((const float*)((const float*)args.in[7]))
#define f1u ((const float*)((const float*)args.in[8]))
#define f1d ((const float*)((const float*)args.in[9]))
#define mixn ((const float*)((const float*)args.in[10]))
#define w_in ((const float*)((const float*)args.in[11]))
#define w_a_up ((const float*)((const float*)args.in[12]))
#define b_a ((const float*)((const float*)args.in[13]))
#define gnw ((const float*)((const float*)args.in[14]))
#define qnw ((const float*)((const float*)args.in[15]))
#define w_uq ((const float*)((const float*)args.in[16]))
#define kvnw ((const float*)((const float*)args.in[17]))
#define w_uk ((const float*)((const float*)args.in[18]))
#define w_uv ((const float*)((const float*)args.in[19]))
#define w_out ((const float*)((const float*)args.in[20]))
#define f2n ((const float*)((const float*)args.in[21]))
#define f2g ((const float*)((const float*)args.in[22]))
#define f2u ((const float*)((const float*)args.in[23]))
#define f2d ((const float*)((const float*)args.in[24]))
#define fnw ((const float*)((const float*)args.in[25]))
#define WGU1 ((bf16_t*)((bf16_t*)(ws + B_WGU1)))
#define WD1 ((bf16_t*)((bf16_t*)(ws + B_WD1)))
#define WIN ((bf16_t*)((bf16_t*)(ws + B_WIN)))
#define WOUT ((bf16_t*)((bf16_t*)(ws + B_WOUT)))
#define WGU2 ((bf16_t*)((bf16_t*)(ws + B_WGU2)))
#define WD2 ((bf16_t*)((bf16_t*)(ws + B_WD2)))
#define XB ((bf16_t*)((bf16_t*)(ws + B_XB)))
#define SSQ0 ((float*)((float*)(ws + B_SSQ0)))
#define H ((bf16_t*)((bf16_t*)(ws + B_H)))
#define X1 ((float*)((float*)(ws + B_X1)))
#define X1B ((bf16_t*)((bf16_t*)(ws + B_X1B)))
#define SSQ1 ((float*)((float*)(ws + B_SSQ1)))
#define X2 ((float*)((float*)(ws + B_X2)))
#define X2B ((bf16_t*)((bf16_t*)(ws + B_X2B)))
#define SSQ2 ((float*)((float*)(ws + B_SSQ2)))
#define X3 ((float*)((float*)(ws + B_X3)))
#define X3B ((bf16_t*)((bf16_t*)(ws + B_X3B)))
#define SSQ3 ((float*)((float*)(ws + B_SSQ3)))
#define YMIXB ((bf16_t*)((bf16_t*)(ws + B_YMIXB)))
#define PROJ ((float*)((float*)(ws + B_PROJ)))
#define OG ((float*)((float*)(ws + B_OG)))
#define QF ((float*)((float*)(ws + B_QF)))
#define LAT ((float*)((float*)(ws + B_LAT)))
#define KPE ((float*)((float*)(ws + B_KPE)))
#define KN ((float*)((float*)(ws + B_KN)))
#define VV ((float*)((float*)(ws + B_VV)))
#define CQN ((float*)((float*)(ws + B_CQN)))
#define QLAT ((float*)((float*)(ws + B_QLAT)))
#define OLAT ((float*)((float*)(ws + B_OLAT)))
#define WQA ((bf16_t*)((bf16_t*)(ws + B_WQA)))
#define RT ((float2*)((float2*)(ws + B_RT)))
#define CQB ((bf16_t*)((bf16_t*)(ws + B_CQB)))
#define CQS ((float*)((float*)(ws + B_CQS)))
#define CKV ((float*)((float*)(ws + B_CKV)))
#define KPR ((float*)((float*)(ws + B_KPR)))
#define KL ((bf16_t*)((bf16_t*)(ws + B_KL)))
#define QA ((bf16_t*)((bf16_t*)(ws + B_QA)))
#define QG ((bf16_t*)((bf16_t*)(ws + B_QG)))
#define KG ((bf16_t*)((bf16_t*)(ws + B_KG)))
#define VT ((bf16_t*)((bf16_t*)(ws + B_VT)))
#define VS ((float*)((float*)(ws + B_VS)))
#define SG ((bf16_t*)((bf16_t*)(ws + B_SG)))
#define ALOW ((float*)((float*)(ws + B_ALOW)))
#define DEC ((float*)((float*)(ws + B_DEC)))
#define UT ((bf16_t*)(ws + B_UT))
#define ST ((bf16_t*)((bf16_t*)(ws + B_ST)))
#define PART ((float*)(ws + B_PART))
    const Rows2 Xin{x_p, x_s, MP, DM};

    const int lo = args.ph_lo, hi = args.ph_hi;
#define IN(k) (lo <= (k) && (k) < hi)
#define SEAM(k) do { if (IN(k) && IN((k) + 1)) xcd_barrier(bar); } while (0)

    if (IN(0)) {
        LAS float* scr = (LAS float*)ldsl + wave * 4160;
        constexpr int I_G = 16 * 44, I_D = 44 * 16, I_IN = 16 * 32, I_OUT = 8 * 16;
        constexpr int NIT = 6 * I_G + I_IN + I_OUT;
        static_assert(I_G == I_D, "items");
        for (int it = gw; it < NIT; it += ngw) {
            int r = it;
            if (r < I_G) { tr_item(f1g, DM, DFF, f1n, WGU1, MapGU{0}, scr, r, lane); continue; } r -= I_G;
            if (r < I_G) { tr_item(f1u, DM, DFF, f1n, WGU1, MapGU{128}, scr, r, lane); continue; } r -= I_G;
            if (r < I_D) { tr_item(f1d, DFF, DM, nullptr, WD1, MapId{}, scr, r, lane); continue; } r -= I_D;
            if (r < I_G) { tr_item(f2g, DM, DFF, f2n, WGU2, MapGU{0}, scr, r, lane); continue; } r -= I_G;
            if (r < I_G) { tr_item(f2u, DM, DFF, f2n, WGU2, MapGU{128}, scr, r, lane); continue; } r -= I_G;
            if (r < I_D) { tr_item(f2d, DFF, DM, nullptr, WD2, MapId{}, scr, r, lane); continue; } r -= I_D;
            if (r < I_IN) { tr_item(w_in, DM, INW, mixn, WIN, MapWin{}, scr, r, lane); continue; } r -= I_IN;
            tr_item(w_out, 512, DM, nullptr, WOUT, MapId{}, scr, r, lane, DM);
        }
        for (int it = gw; it < 2048; it += ngw) { const int ng = it & 15, cg = (it >> 4) & 31, h = it >> 9, n = ng * 64 + lane;
            const float* wv = w_uv + (size_t)(cg * 4) * 512 + h * 128; const float* wo = w_out + (size_t)(512 + h * 128) * DM + n; float s0 = 0.f, s1 = 0.f, s2 = 0.f, s3 = 0.f;
#pragma unroll 32
            for (int d = 0; d < 128; ++d) { const float o = wo[(size_t)d * DM]; s0 += wv[d] * o; s1 += wv[512 + d] * o; s2 += wv[1024 + d] * o; s3 += wv[1536 + d] * o; }
            u32x2 w; w.x = pg8::cvt_pk_bf16(s0, s1); w.y = pg8::cvt_pk_bf16(s2, s3); *(u32x2*)(WOUT + (size_t)n * DM + 512 + h * 128 + cg * 4) = w; }
        for (int it = gw; it < 512; it += ngw) { const int kg4 = it & 3, cg = (it >> 2) & 31, h = it >> 7, k = kg4 * 64 + lane;
            const f32x4* wq = (const f32x4*)(w_uq + (size_t)k * 768 + h * 192); const float* wk = w_uk + (size_t)(cg * 4) * 512 + h * 128; float s0 = 0.f, s1 = 0.f, s2 = 0.f, s3 = 0.f;
#pragma unroll 16
            for (int d4 = 0; d4 < 32; ++d4) { const f32x4 q = wq[d4];
#pragma unroll
                for (int e = 0; e < 4; ++e) { const int d = 4 * d4 + e; s0 += q[e] * wk[d]; s1 += q[e] * wk[512 + d]; s2 += q[e] * wk[1024 + d]; s3 += q[e] * wk[1536 + d]; } }
            const float g = qnw[k]; bf16_t* dst = WQA + (size_t)(h * 128 + cg * 4) * 256 + k;
            const unsigned lo = pg8::cvt_pk_bf16(s0 * g, s1 * g), hi = pg8::cvt_pk_bf16(s2 * g, s3 * g);
            dst[0] = (bf16_t)(lo & 0xffffu); dst[256] = (bf16_t)(lo >> 16); dst[512] = (bf16_t)(hi & 0xffffu); dst[768] = (bf16_t)(hi >> 16); }
        for (int e = gtid; e < 256 * 256; e += gthr) { const int k = e & 255, rr = e >> 8, h = rr >> 6, j = rr & 63, i = j >> 1, ee = j & 1;
            WQA[(size_t)(512 + rr) * 256 + k] = (bf16_t)(pg8::cvt_pk_bf16(w_uq[(size_t)k * 768 + h * 192 + 128 + 32 * ee + i] * qnw[k], 0.f) & 0xffffu); }
        for (int e = gtid; e < 2049 * 32; e += gthr) { const int i = e & 31, p = e >> 5; float c, s; rope_cs(p < SEQ ? p : PAST, i, c, s); RT[e] = make_float2(c, s); }
        for (int e = gtid; e < 48 * 1024 / 8; e += gthr) ((u32x4*)(WIN + (size_t)2000 * 1024))[e] = (u32x4){0u, 0u, 0u, 0u};
        for (int r4 = gw; r4 < MT / 4; r4 += ngw) {
            float4 v[4][4]; float s[4];
#pragma unroll
            for (int q = 0; q < 4; ++q) { const float4* p = (const float4*)Xin.row(4 * r4 + q) + lane;
#pragma unroll
                for (int j = 0; j < 4; ++j) v[q][j] = p[64 * j]; }
#pragma unroll
            for (int q = 0; q < 4; ++q) { s[q] = 0.f;
#pragma unroll
                for (int j = 0; j < 4; ++j) s[q] += (v[q][j].x * v[q][j].x + v[q][j].y * v[q][j].y) + (v[q][j].z * v[q][j].z + v[q][j].w * v[q][j].w); }
#pragma unroll
            for (int o = 1; o < 64; o <<= 1) {
#pragma unroll
                for (int q = 0; q < 4; ++q) s[q] += __shfl_xor(s[q], o); }
#pragma unroll
            for (int q = 0; q < 4; ++q) { const float rs = 1.0f / sqrtf(s[q] * (1.f / 1024.f) + EPS);
#pragma unroll
                for (int j = 0; j < 4; ++j) { u32x2 w; w.x = pg8::cvt_pk_bf16(v[q][j].x * rs, v[q][j].y * rs); w.y = pg8::cvt_pk_bf16(v[q][j].z * rs, v[q][j].w * rs); ((u32x2*)(XB + (size_t)(4 * r4 + q) * DM))[lane + 64 * j] = w; } }
        }
    } SEAM(0);
    if (IN(1)) {
        sk_swiglu<false>(ldsl, XB + (size_t)MP * DM, WGU1, H + (size_t)MP * DFF, lane, wave);
        pg8::Gemm g{XB, WGU1, MP, 2 * DFF, DM}; pg8::StaticOrder S; S.init(MP, 2 * DFF, gridDim.x, (int)blockIdx.x);
        EpiSwigluB<false> E{H, SSQ0, 1, RsTab{-1, -1, -1, -1, nullptr}}; pg8::gemm_phase<EpiSwigluB<false>, pg8::StaticOrder, PG8_ALIGN, PG8_SP2>(ldsl, g, S, E); } SEAM(1);
    if (IN(2)) {
        sk_resid(ldsl, H + (size_t)MP * DFF, DFF, WD1, x_s, X1 + (size_t)MP * DM, X1B + (size_t)MP * DM, 0.5f, lane, wave);
        pg8::Gemm g{H, WD1, MP, DM, DFF}; pg8::StaticOrder S; S.init(MP, DM, gridDim.x, (int)blockIdx.x);
        EpiResidB<false> E{x_p, nullptr, X1B, SSQ1, 0.5f}; pg8::gemm_phase<EpiResidB<false>, pg8::StaticOrder, PG8_ALIGN, PG8_SP2>(ldsl, g, S, E); } SEAM(2);
    if (IN(3)) {
        sk_proj(ldsl, X1B + (size_t)MP * DM, WIN, QG + (size_t)MP * 256, KG + (size_t)MP * 256, VS, SG + (size_t)MP * 512, CQB + (size_t)MP * 256, CKV + (size_t)MP * 128, KPR + (size_t)MP * 64, ALOW + (size_t)MP * 16, lane, wave);
        { pg8::Gemm g{X1B, WIN, MP, 2048, DM}; SkipVOrder S; S.init(MP, 1536, gridDim.x, (int)blockIdx.x);
          const RsTab RT3 = build_rstab(ldsl, S, SSQ1, tid); EpiProj2 E{PROJ, SSQ1, RT3, CQB, CQS, CKV, KPR, QG, KG, VT, VS, SG, ALOW}; pg8::gemm_phase<EpiProj2, SkipVOrder, PG8_ALIGN, PG8_SP2>(ldsl, g, S, E); }
        { pg8::Gemm gv{WIN + (size_t)C_V * DM, X1B, 512, MP, DM};
          pg8::Unit uv; LAS float* tab = (LAS float*)(ldsl + RSTAB_OFF);
#pragma unroll 1
          for (int L = (int)blockIdx.x; L < 256; L += (int)gridDim.x) { const int wg = (L & 7) * 32 + (L >> 3); uv.pm = wg & 1; uv.pn = wg >> 1;
              __syncthreads();
              if (tid < 256) tab[tid] = rstd_from(SSQ1, 16, uv.pn * 256 + tid);
              __syncthreads();
              OneUnit O1{uv}; EpiVT EV{VT, (const LAS float*)tab}; pg8::gemm_phase<EpiVT, OneUnit, PG8_ALIGN, PG8_SP2>(ldsl, gv, O1, EV); } } } SEAM(3);
    if (IN(4)) {
        for (int r4 = gw; r4 < MT / 4; r4 += ngw) {
            float2 cv[4]; float x1[4], x2[4]; float2 cs[4]; float ss[4];
#pragma unroll
            for (int q = 0; q < 4; ++q) { const int r = 4 * r4 + q; const int pidx = r < MP ? (r & (SEQ - 1)) : SEQ;
                cv[q] = *(const float2*)(CKV + (size_t)r * 128 + lane * 2);
                x1[q] = KPR[(size_t)r * 64 + (lane & 31)]; x2[q] = KPR[(size_t)r * 64 + 32 + (lane & 31)]; cs[q] = RT[(size_t)pidx * 32 + (lane & 31)]; }
#pragma unroll
            for (int q = 0; q < 4; ++q) ss[q] = cv[q].x * cv[q].x + cv[q].y * cv[q].y;
#pragma unroll
            for (int o = 1; o < 64; o <<= 1) {
#pragma unroll
                for (int q = 0; q < 4; ++q) ss[q] += __shfl_xor(ss[q], o); }
            const float2 w = *(const float2*)(kvnw + lane * 2);
#pragma unroll
            for (int q = 0; q < 4; ++q) { const int r = 4 * r4 + q;
                const float rstd = 1.0f / sqrtf(ss[q] * (1.f / 128.f) + EPS);
                const float2 y = make_float2(cv[q].x * rstd * w.x, cv[q].y * rstd * w.y);
                float* o = r < MP ? out + O_KVP + (size_t)r * 128 : out + O_KVS + (size_t)(r - MP) * 128;
                *(float2*)(o + lane * 2) = y;
                *(unsigned*)(KL + (size_t)r * 192 + lane * 2) = pg8::cvt_pk_bf16(y.x, y.y);
                if (lane < 32) {
                    const float y1 = x1[q] * cs[q].x - x2[q] * cs[q].y, y2 = x1[q] * cs[q].y + x2[q] * cs[q].x;
                    float* op = r < MP ? out + O_PEP + (size_t)r * 64 : out + O_PES + (size_t)(r - MP) * 64;
                    op[lane] = y1; op[32 + lane] = y2;
                    *(unsigned*)(KL + (size_t)r * 192 + 128 + 2 * lane) = pg8::cvt_pk_bf16(y1, y2); } }
        }
        for (int u = gw; u < 2048; u += ngw) gla_prep_unit(ldsl + wave * KTT_BYTES, QG, KG, ALOW, w_a_up, b_a, VT, DEC, UT, u, lane);
        __syncthreads();
        { pg8::Gemm g{CQB, WQA, MP, 768, 256}; pg8::StaticOrder S; S.init(MP, 768, gridDim.x, (int)blockIdx.x);
          EpiQabs E{QA, CQS, RT}; pg8::gemm_phase<EpiQabs, pg8::StaticOrder, PG8_ALIGN, PG8_SP2>(ldsl, g, S, E); }
        sk_qabs(ldsl, CQB + (size_t)MP * 256, WQA, QA + (size_t)MP * 768, lane, wave);
    } SEAM(4);
    if (IN(5)) {
        const bool memfirst = ((blockIdx.x >> 3) & 1) != 0;
        if (memfirst) {
        for (int it = blockIdx.x; it < 256; it += gridDim.x) decode_item_mfma(ldsl, QA, RT, cache_kv, cache_pe, page_table, PART, it, tid, lane, wave);
        }
        for (int p2 = 2 * blockIdx.x; p2 < 512; p2 += 2 * gridDim.x)
#pragma unroll 1
            for (int hf = 0; hf < 2; ++hf) { const int p = p2 >> 1, b = p >> 4, qq = p & 15; mla_attn_unit(ldsl, QA, KL, RT, YMIXB, b, hf ? qq : 31 - qq, tid, lane, wave); }
        __syncthreads();
        if (!memfirst) {
        for (int it = blockIdx.x; it < 256; it += gridDim.x) decode_item_mfma(ldsl, QA, RT, cache_kv, cache_pe, page_table, PART, it, tid, lane, wave);
        }
        for (int e0 = gtid; e0 < 64 * 64 * 64; e0 += gthr) { const int d = e0 & 63, vp = (e0 >> 6) & 63, bh = e0 >> 12;
            const size_t b0 = (size_t)(bh * 32) * 8192 + (size_t)(2 * vp) * 64 + d;
            bf16_t u0[32], u1[32]; float dc[32];
#pragma unroll
            for (int c = 0; c < 32; ++c) { u0[c] = UT[b0 + (size_t)c * 8192]; u1[c] = UT[b0 + (size_t)c * 8192 + 64]; dc[c] = DEC[(size_t)(bh * 32 + c) * 64 + d]; }
            float S0 = 0.f, S1 = 0.f; bf16_t s0[32], s1[32];
#pragma unroll
            for (int c = 0; c < 32; ++c) { const unsigned pk = pg8::cvt_pk_bf16(S0, S1); s0[c] = (bf16_t)(pk & 0xffffu); s1[c] = (bf16_t)(pk >> 16);
                S0 = dc[c] * (S0 + bf2f(u0[c])); S1 = dc[c] * (S1 + bf2f(u1[c])); }
#pragma unroll
            for (int c = 0; c < 32; ++c) { ST[b0 + (size_t)c * 8192] = s0[c]; ST[b0 + (size_t)c * 8192 + 64] = s1[c]; }
            out[O_GLP + ((size_t)bh * 64 + d) * 128 + 2 * vp] = S0; out[O_GLP + ((size_t)bh * 64 + d) * 128 + 2 * vp + 1] = S1;
        }
        for (int it = wave * (int)gridDim.x + (int)blockIdx.x; it < MS * 4; it += ngw) {
            const int h = it & 3, bb = it >> 2; const size_t row = (size_t)MP + bb;
            float xg = b_a[h * 64 + lane];
#pragma unroll
            for (int r = 0; r < 16; ++r) xg += ALOW[row * 16 + r] * w_a_up[r * 256 + h * 64 + lane];
            const int ad = __float_as_int(expf(logsig_f(xg) * (1.f / 16.f))), qd = __float_as_int(bf2f(QG[row * 256 + h * 64 + lane])), kd = __float_as_int(bf2f(KG[row * 256 + h * 64 + lane]));
            const float2 vv = *(const float2*)(VS + (size_t)bb * 512 + h * 128 + 2 * lane);
            const float* st = state_gla + ((size_t)(bb * 4 + h) * 64) * 128 + 2 * lane; float* dst = out + O_GLS + ((size_t)(bb * 4 + h) * 64) * 128 + 2 * lane;
            float o0 = 0.f, o1 = 0.f;
            float2 sv[64];
#pragma unroll
            for (int dd = 0; dd < 64; ++dd) sv[dd] = *(const float2*)(st + dd * 128);
#pragma unroll
            for (int dd = 0; dd < 64; ++dd) { const float a = __int_as_float(__builtin_amdgcn_readlane(ad, dd)), q = __int_as_float(__builtin_amdgcn_readlane(qd, dd)), k = __int_as_float(__builtin_amdgcn_readlane(kd, dd));
                const float S0 = a * sv[dd].x + k * vv.x, S1 = a * sv[dd].y + k * vv.y; o0 += q * S0; o1 += q * S1; *(float2*)(dst + dd * 128) = make_float2(S0, S1); }
            const float rstd = 1.0f / sqrtf(wave_sum(o0 * o0 + o1 * o1) * (1.f / 128.f) + EPS);
            const float2 gn = *(const float2*)(gnw + 2 * lane); const unsigned sg = *(const unsigned*)(SG + row * 512 + h * 128 + 2 * lane);
            *(unsigned*)(YMIXB + row * DM + h * 128 + 2 * lane) = pg8::cvt_pk_bf16(o0 * rstd * gn.x * __uint_as_float(sg << 16), o1 * rstd * gn.y * __uint_as_float(sg & 0xffff0000u));
        }
    } SEAM(5);
    if (IN(6)) {
        for (int u = gw; u < 4096; u += ngw) gla_out_unit(ldsl + wave * GD_BYTES, QG, KG, VT, ST, SG, gnw, YMIXB, u, lane);
        for (int e = gw; e < MS * 4; e += ngw) { const int h = e & 3, bs = e >> 2; const size_t qrow = (size_t)(MP + bs);
            float part;
            {   const unsigned ql = *(const unsigned*)(QA + qrow * 768 + h * 128 + 2 * lane), kl = *(const unsigned*)(KL + qrow * 192 + 2 * lane);
                part = __uint_as_float(ql << 16) * __uint_as_float(kl << 16) + __uint_as_float(ql & 0xffff0000u) * __uint_as_float(kl & 0xffff0000u); }
            if (lane < 32) { const unsigned qp = *(const unsigned*)(QA + qrow * 768 + 512 + h * 64 + 2 * lane), kp = *(const unsigned*)(KL + qrow * 192 + 128 + 2 * lane); const float2 cs = RT[(size_t)SEQ * 32 + lane];
                const float x1 = __uint_as_float(qp << 16), x2 = __uint_as_float(qp & 0xffff0000u); part += (x1 * cs.x - x2 * cs.y) * __uint_as_float(kp << 16) + (x1 * cs.y + x2 * cs.x) * __uint_as_float(kp & 0xffff0000u); }
            const float sn = wave_sum(part);
            const float* p0 = PART + (size_t)((bs * 2) * 4 + h) * 132; const float* p1 = PART + (size_t)((bs * 2 + 1) * 4 + h) * 132;
            const float M0 = p0[128], M1 = p1[128], M = fmaxf(fmaxf(M0, M1), sn), f0 = __builtin_amdgcn_exp2f(M0 - M), f1 = __builtin_amdgcn_exp2f(M1 - M), fn = __builtin_amdgcn_exp2f(sn - M);
            const float il = 1.0f / (p0[129] * f0 + p1[129] * f1 + fn);
            const unsigned vl = *(const unsigned*)(KL + qrow * 192 + 2 * lane);
            const float2 a0 = *(const float2*)(p0 + 2 * lane), a1 = *(const float2*)(p1 + 2 * lane);
            const float o0 = (a0.x * f0 + a1.x * f1 + fn * __uint_as_float(vl << 16)) * il, o1 = (a0.y * f0 + a1.y * f1 + fn * __uint_as_float(vl & 0xffff0000u)) * il;
            *(unsigned*)(YMIXB + qrow * DM + 512 + h * 128 + 2 * lane) = pg8::cvt_pk_bf16(o0, o1); }
    } SEAM(6);
    if (IN(7)) {
        sk_resid(ldsl, YMIXB + (size_t)MP * DM, DM, WOUT, X1 + (size_t)MP * DM, X2 + (size_t)MP * DM, X2B + (size_t)MP * DM, 1.0f, lane, wave);
        pg8::Gemm g{YMIXB, WOUT, MP, DM, DM}; pg8::StaticOrder S; S.init(MP, DM, gridDim.x, (int)blockIdx.x);
        EpiResidB<true> E{nullptr, X1B, X2B, SSQ2, 1.0f}; pg8::gemm_phase<EpiResidB<true>, pg8::StaticOrder, PG8_ALIGN, PG8_SP2>(ldsl, g, S, E); } SEAM(7);
    if (IN(8)) {
        sk_swiglu<true>(ldsl, X2B + (size_t)MP * DM, WGU2, H + (size_t)MP * DFF, lane, wave);
        pg8::Gemm g{X2B, WGU2, MP, 2 * DFF, DM}; pg8::StaticOrder S; S.init(MP, 2 * DFF, gridDim.x, (int)blockIdx.x);
        const RsTab RT8 = build_rstab(ldsl, S, SSQ2, tid); EpiSwigluB<true> E{H, SSQ2, 16, RT8}; pg8::gemm_phase<EpiSwigluB<true>, pg8::StaticOrder, PG8_ALIGN, PG8_SP2>(ldsl, g, S, E); } SEAM(8);
    if (IN(9)) {
        sk_resid(ldsl, H + (size_t)MP * DFF, DFF, WD2, X2 + (size_t)MP * DM, X3 + (size_t)MP * DM, X3B + (size_t)MP * DM, 0.5f, lane, wave);
        pg8::Gemm g{H, WD2, MP, DM, DFF}; pg8::StaticOrder S; S.init(MP, DM, gridDim.x, (int)blockIdx.x);
        EpiResidB<true> E{nullptr, X2B, X3B, SSQ3, 0.5f}; pg8::gemm_phase<EpiResidB<true>, pg8::StaticOrder, PG8_ALIGN, PG8_SP2>(ldsl, g, S, E); } SEAM(9);
    if (IN(10)) {
        for (int r4 = gw; r4 < MP / 8; r4 += ngw) {
            u32x4 raw[8][2]; float s[8];
#pragma unroll
            for (int q = 0; q < 8; ++q)
#pragma unroll
                for (int j = 0; j < 2; ++j) raw[q][j] = *(const u32x4*)(X3B + (size_t)(8 * r4 + q) * DM + 512 * j + 8 * lane);
            f32x4 w[4];
#pragma unroll
            for (int j = 0; j < 2; ++j) { w[2 * j] = *(const f32x4*)(fnw + 512 * j + 8 * lane); w[2 * j + 1] = *(const f32x4*)(fnw + 512 * j + 8 * lane + 4); }
#pragma unroll
            for (int q = 0; q < 8; ++q) { s[q] = 0.f;
#pragma unroll
                for (int j = 0; j < 2; ++j)
#pragma unroll
                    for (int e = 0; e < 4; ++e) { const unsigned u = raw[q][j][e]; const float a = __uint_as_float(u << 16), b = __uint_as_float(u & 0xffff0000u); s[q] += a * a + b * b; } }
#pragma unroll
            for (int o = 1; o < 64; o <<= 1) {
#pragma unroll
                for (int q = 0; q < 8; ++q) s[q] += __shfl_xor(s[q], o); }
#pragma unroll
            for (int q = 0; q < 8; ++q) { const float rstd = 1.0f / sqrtf(s[q] * (1.f / 1024.f) + EPS);
#pragma unroll
                for (int j = 0; j < 2; ++j) { const u32x4 u = raw[q][j];
                    const f32x4 v0 = (f32x4){__uint_as_float(u.x << 16), __uint_as_float(u.x & 0xffff0000u), __uint_as_float(u.y << 16), __uint_as_float(u.y & 0xffff0000u)};
                    const f32x4 v1 = (f32x4){__uint_as_float(u.z << 16), __uint_as_float(u.z & 0xffff0000u), __uint_as_float(u.w << 16), __uint_as_float(u.w & 0xffff0000u)};
                    float* op = out + O_YP + (size_t)(8 * r4 + q) * DM + 512 * j + 8 * lane;
                    *(f32x4*)op = v0 * rstd * w[2 * j]; *(f32x4*)(op + 4) = v1 * rstd * w[2 * j + 1]; } }
        }
        rms_rows_1024(Rows2{X3 + (size_t)MP * DM, X3 + (size_t)MP * DM, MS, DM}, fnw, out + O_YS, MS);
    }
#undef IN
#undef SEAM
}
#undef lds
#undef ldsl
#undef MISC
#undef tid
#undef lane
#undef wave
#undef gtid
#undef gthr
#undef gw
#undef ngw
#undef x_p
#undef x_s
#undef cache_kv
#undef cache_pe
#undef state_gla
#undef page_table
#undef f1n
#undef f1g
#undef f1u
#undef f1d
#undef mixn
#undef w_in
#undef w_a_up
#undef b_a
#undef gnw
#undef qnw
#undef w_uq
#undef kvnw
#undef w_uk
#undef w_uv
#undef w_out
#undef f2n
#undef f2g
#undef f2u
#undef f2d
#undef fnw
#undef WGU1
#undef WD1
#undef WIN
#undef WOUT
#undef WGU2
#undef WD2
#undef XB
#undef SSQ0
#undef H
#undef X1
#undef X1B
#undef SSQ1
#undef X2
#undef X2B
#undef SSQ2
#undef X3
#undef X3B
#undef SSQ3
#undef YMIXB
#undef PROJ
#undef OG
#undef QF
#undef LAT
#undef KPE
#undef KN
#undef VV
#undef CQN
#undef QLAT
#undef OLAT
#undef WQA
#undef RT
#undef CQB
#undef CQS
#undef CKV
#undef KPR
#undef KL
#undef QA
#undef QG
#undef KG
#undef VT
#undef VS
#undef SG
#undef ALOW
#undef DEC
#undef UT
#undef ST
#undef PART

extern "C" void kernel_launch(void* const* d_in, const int* in_sizes, int n_in, void* d_out, int out_size, void* d_ws, size_t ws_size, hipStream_t stream) {
    static int grid = 0;
    if (grid == 0) {
        if (n_in != 26 || (size_t)out_size != O_END || ws_size < B_END) { fprintf(stderr, "kernel_launch: unexpected sizes n_in %d out %d ws %zu (need %zu)\n", n_in, out_size, ws_size, (size_t)B_END); grid = -1; return; }
        int dev = 0, cus = 0;
        if (hipGetDevice(&dev) != hipSuccess || hipDeviceGetAttribute(&cus, hipDeviceAttributeMultiprocessorCount, dev) != hipSuccess) { grid = -1; return; }
        if (hipFuncSetAttribute((const void*)fwd_kernel, hipFuncAttributeMaxDynamicSharedMemorySize, LDS_BYTES) != hipSuccess) { fprintf(stderr, "hipFuncSetAttribute failed\n"); grid = -1; return; }
        int per_cu = 0;
        if (hipOccupancyMaxActiveBlocksPerMultiprocessor(&per_cu, (const void*)fwd_kernel, NTHR, LDS_BYTES) != hipSuccess || per_cu < 1) fprintf(stderr, "occupancy query: %d\n", per_cu);
        (void)hipGetLastError();
        grid = cus;
    }
    if (grid < 0) return;
    (void)hipMemsetAsync(d_ws, 0, WS_CTL_BYTES, stream);
    Args a{};
    for (int i = 0; i < 26; ++i) a.in[i] = d_in[i];
    a.out = (float*)d_out; a.ws = (unsigned char*)d_ws; a.pad = 0;
#if MK_ONE_LAUNCH
    a.ph_lo = 0; a.ph_hi = NPHASE; a.one = 1;
    hipLaunchKernelGGL(fwd_kernel, dim3(grid), dim3(NTHR), LDS_BYTES, stream, a);
#else
    for (int p = 0; p < NPHASE; ++p) { a.ph_lo = p; a.ph_hi = p + 1; a.one = 0; hipLaunchKernelGGL(fwd_kernel, dim3(grid), dim3(NTHR), LDS_BYTES, stream, a); }
#endif
}
```

```cpp
#include <hip/hip_runtime.h>
#include <cstdio>
#include <cstdint>

#ifndef MK_ONE_LAUNCH
#define MK_ONE_LAUNCH 1
#endif

constexpr int DM = 1024, BATCH = 16, SEQ = 2048, DECB = 128, PAST = 8192, PAGE = 128, NPAGES = PAST / PAGE;
constexpr int DFF = 2816, INW = 2000;
constexpr int MP = BATCH * SEQ, MS = DECB, MT = MP + MS;
constexpr int MPAD = 33024, PAD_PM = 128;
constexpr float EPS = 1e-6f;
constexpr float MLA_SCALE = 0.07216878364870322f;
constexpr int C_Q = 0, C_K = 256, C_V = 512, C_G = 1024, C_A = 1536, C_CQ = 1552, C_CKV = 1808, C_KPE = 1936;
constexpr size_t O_YP = 0, O_YS = (size_t)MP * DM, O_KVP = O_YS + (size_t)MS * DM, O_PEP = O_KVP + (size_t)MP * 128, O_GLP = O_PEP + (size_t)MP * 64,
                 O_KVS = O_GLP + (size_t)BATCH * 4 * 64 * 128, O_PES = O_KVS + (size_t)MS * 128, O_GLS = O_PES + (size_t)MS * 64, O_END = O_GLS + (size_t)MS * 4 * 64 * 128;

constexpr size_t al256(size_t x) { return (x + 255) & ~(size_t)255; }
constexpr size_t WS_CTL_BYTES = 1u << 20;
constexpr size_t B_WGU1 = WS_CTL_BYTES, B_WD1 = B_WGU1 + (size_t)5632 * 1024 * 2, B_WIN = B_WD1 + (size_t)1024 * 2816 * 2, B_WOUT = B_WIN + (size_t)2048 * 1024 * 2,
                 B_WGU2 = B_WOUT + (size_t)1024 * 1024 * 2, B_WD2 = B_WGU2 + (size_t)5632 * 1024 * 2, B_XB = B_WD2 + (size_t)1024 * 2816 * 2,
                 B_SSQ0 = B_XB + (size_t)MPAD * DM * 2, B_H = al256(B_SSQ0 + (size_t)MPAD * 4), B_X1 = B_H + (size_t)MPAD * DFF * 2, B_X1B = B_X1 + (size_t)MPAD * DM * 4,
                 B_SSQ1 = B_X1B + (size_t)MPAD * DM * 2, B_X2 = B_SSQ1 + (size_t)MPAD * 64, B_X2B = B_X2 + (size_t)MPAD * DM * 4, B_SSQ2 = B_X2B + (size_t)MPAD * DM * 2,
                 B_X3 = B_SSQ2 + (size_t)MPAD * 64, B_X3B = B_X3 + (size_t)MPAD * DM * 4, B_SSQ3 = B_X3B + (size_t)MPAD * DM * 2, B_YMIXB = B_SSQ3 + (size_t)MPAD * 64,
                 B_PROJ = B_YMIXB + (size_t)MPAD * DM * 2, B_OG = B_PROJ + (size_t)MT * INW * 4, B_QF = B_OG + (size_t)MT * 512 * 4, B_LAT = B_QF + (size_t)MT * 768 * 4,
                 B_KPE = B_LAT + (size_t)MT * 128 * 4, B_KN = B_KPE + (size_t)MT * 64 * 4, B_VV = B_KN + (size_t)MT * 512 * 4, B_CQN = B_VV + (size_t)MT * 512 * 4,
                 B_QLAT = B_CQN + (size_t)MT * 256 * 4, B_OLAT = B_QLAT + (size_t)MS * 512 * 4,
                 B_WQA = al256(B_OLAT + (size_t)MS * 512 * 4), B_RT = B_WQA + (size_t)768 * 256 * 2, B_CQB = al256(B_RT + (size_t)2049 * 32 * 8), B_CQS = B_CQB + (size_t)MPAD * 256 * 2,
                 B_CKV = B_CQS + (size_t)MPAD * 16, B_KPR = B_CKV + (size_t)MPAD * 128 * 4, B_KL = B_KPR + (size_t)MPAD * 64 * 4, B_QA = B_KL + (size_t)MPAD * 192 * 2,
                 B_QG = B_QA + (size_t)MPAD * 768 * 2, B_KG = B_QG + (size_t)MPAD * 256 * 2, B_VT = B_KG + (size_t)MPAD * 256 * 2, B_VS = B_VT + (size_t)64 * 128 * 2048 * 2,
                 B_SG = B_VS + (size_t)MS * 512 * 4, B_ALOW = B_SG + (size_t)MPAD * 512 * 2, B_DEC = B_ALOW + (size_t)MPAD * 16 * 4, B_UT = B_DEC + (size_t)2048 * 64 * 4,
                 B_ST = B_UT + (size_t)2048 * 128 * 64 * 4, B_PART = B_ST + (size_t)2048 * 128 * 64 * 2, B_END = B_PART + (size_t)256 * 4 * 132 * 4;

#define LAS __attribute__((address_space(3)))
constexpr int NTHR = 512;
constexpr int LDS_BYTES = 147456;
constexpr int MISC_OFF = 147456 - 256;

#define XB_TMO      128
#define XB_XCNT(j)  (256  + 64 * (j))
#define XB_XSUB(j)  (1280 + 64 * (j))
#define XB_XGEN(j)  (2304 + 64 * (j))
#define XB_TOP      3328
#define XB_TOPGEN   3392
#define XCD_BAR_WORDS 3456
#define XB_SPIN_CAP (1u << 25)
__device__ __forceinline__ unsigned xb_ld(unsigned* p)              { return __hip_atomic_load(p, __ATOMIC_RELAXED, __HIP_MEMORY_SCOPE_AGENT); }
__device__ __forceinline__ unsigned xb_add(unsigned* p, unsigned v) { return __hip_atomic_fetch_add(p, v, __ATOMIC_RELAXED, __HIP_MEMORY_SCOPE_AGENT); }
__device__ __forceinline__ unsigned xb_xcc_id() { return (unsigned)__builtin_amdgcn_s_getreg((3 << 11) | 20) & 0xFu; }
#define XB_SPIN(cond, bar) do { unsigned _sp = 0; while (cond) { __builtin_amdgcn_s_sleep(1); \
    if ((++_sp & 255u) == 0u) { if (xb_ld(&(bar)[XB_TMO])) break; if (_sp > XB_SPIN_CAP) { atomicAdd(&(bar)[XB_TMO], 1u); break; } } } } while (0)
struct XcdBarrier { unsigned* bar; unsigned x; volatile LAS unsigned* st; };
__device__ __forceinline__ XcdBarrier xcd_barrier_post(unsigned* bar, volatile LAS unsigned* st) {
    XcdBarrier b; b.bar = bar; b.x = xb_xcc_id(); b.st = st;
    if (threadIdx.x == 0) (void)xb_add(&bar[XB_XCNT(b.x)], 1u);
    return b;
}
__device__ __forceinline__ void xcd_barrier_complete(unsigned* bar, unsigned x, unsigned& nloc, unsigned& nx) {
    const unsigned G = gridDim.x * gridDim.y * gridDim.z;
    unsigned sum, cnt, mine, sp = 0u;
    for (;;) {
        sum = 0u; cnt = 0u; mine = 0u;
#pragma unroll
        for (unsigned j = 0; j < 16; ++j) { const unsigned c = xb_ld(&bar[XB_XCNT(j)]); sum += c; cnt += (c > 0u) ? 1u : 0u; mine = (j == x) ? c : mine; }
        if (sum == G) break;
        __builtin_amdgcn_s_sleep(1);
        if ((++sp & 255u) == 0u) { if (xb_ld(&bar[XB_TMO])) break; if (sp > XB_SPIN_CAP) { atomicAdd(&bar[XB_TMO], 1u); break; } }
    }
    nloc = mine > 0u ? mine : 1u; nx = cnt > 0u ? cnt : 1u;
}
__device__ __forceinline__ void xcd_barrier(const XcdBarrier& b) {
    asm volatile("s_waitcnt vmcnt(0)" ::: "memory");
    __syncthreads();
    if (threadIdx.x == 0) {
        unsigned* bar = b.bar;
        __builtin_amdgcn_s_waitcnt(0);
        unsigned nloc = b.st[0], nx = b.st[1];
        if (nloc == 0u) { xcd_barrier_complete(bar, b.x, nloc, nx); b.st[0] = nloc; b.st[1] = nx; }
        const unsigned old = xb_add(&bar[XB_XSUB(b.x)], 1u);
        const unsigned gen = old / nloc;
        if (old + 1u == (gen + 1u) * nloc) {
            __builtin_amdgcn_fence(__ATOMIC_RELEASE, "agent");
            asm volatile("s_waitcnt vmcnt(0)" ::: "memory");
            const unsigned og = xb_add(&bar[XB_TOP], 1u);
            const unsigned tg = og / nx;
            if (og + 1u == (tg + 1u) * nx) xb_add(&bar[XB_TOPGEN], 1u);
            else XB_SPIN(xb_ld(&bar[XB_TOPGEN]) == tg, bar);
            __builtin_amdgcn_fence(__ATOMIC_ACQUIRE, "agent");
            xb_add(&bar[XB_XGEN(b.x)], 1u);
            asm volatile("s_waitcnt vmcnt(0)" ::: "memory");
        } else {
            XB_SPIN(xb_ld(&bar[XB_XGEN(b.x)]) == gen, bar);
            __builtin_amdgcn_fence(__ATOMIC_ACQUIRE, "agent");
            asm volatile("s_waitcnt vmcnt(0)" ::: "memory");
        }
    }
    __syncthreads();
}

namespace pg8 {
#define PG8_LAS __attribute__((address_space(3)))
typedef unsigned short bf16_t;
typedef short bf16x8 __attribute__((ext_vector_type(8)));
typedef float f32x4 __attribute__((ext_vector_type(4)));
typedef unsigned u32x4 __attribute__((ext_vector_type(4)));
constexpr int BM = 256, BK = 64, HALF = 128, HTB = HALF * BK * 2  , STAGE_BYTES = 8 * HTB, NXCD = 8, WGM = 8;

__host__ __device__ __forceinline__ int lds_byte(int r, int c) { const int st = (r >> 4) * 2 + (c >> 5), rr = r & 15, cc = c & 31, ob = rr * 64 + cc * 2; return st * 1024 + (ob ^ (((ob >> 9) & 1) << 5)); }
__host__ __device__ __forceinline__ void stage_rc(int b, int& R, int& C) { const int st = b / 1024, sb = b % 1024, swz = sb ^ (((sb >> 9) & 1) << 5); R = (st >> 1) * 16 + swz / 64; C = (st & 1) * 32 + (swz % 64) / 2; }
__host__ __device__ __forceinline__ int perm32(int rho) { const int n = rho >> 4, i = rho & 15; return 8 * (i >> 2) + 4 * n + (i & 3); }

struct Unit { int pm, pn; };
struct Gemm { const bf16_t* A; const bf16_t* Bt; int M, N, K; };

struct StaticOrder {
    int nM, nN, nwg, G, c;
    __host__ __device__ void init(int M, int N, int G_, int c_) { nM = M / BM; nN = N / BM; nwg = nM * nN; G = G_; c = c_; }
    __host__ __device__ bool next(int i, Unit& u) const {
        const long L = (long)i * G + c; if (L >= nwg) return false;
        int wgid = (int)L; { const int q = nwg / NXCD, r = nwg % NXCD, xcd = wgid % NXCD, off = wgid / NXCD; wgid = (xcd < r ? xcd * (q + 1) : r * (q + 1) + (xcd - r) * q) + off; }
        const int nig = WGM * nN, gid = wgid / nig, fm = gid * WGM, gsz = (nM - fm) < WGM ? (nM - fm) : WGM;
        u.pm = fm + ((wgid % nig) % gsz); u.pn = (wgid % nig) / gsz; return true;
    }
    __device__ __forceinline__ void a_ready(const Unit&) const {}
    __device__ __forceinline__ void done(const Unit&) const {}
};
__device__ __forceinline__ unsigned cvt_pk_bf16(float lo, float hi) { unsigned r; asm volatile("v_cvt_pk_bf16_f32 %0, %1, %2" : "=v"(r) : "v"(lo), "v"(hi)); return r; }
typedef float f32x2 __attribute__((ext_vector_type(2)));
template <class Epi, class Sched, bool ALIGN_EPI = false, bool SP2 = false>
__device__ __forceinline__ void gemm_phase(PG8_LAS unsigned char* lds, const Gemm g, const Sched& S, const Epi& E) {
    const int tid = threadIdx.x, wid = __builtin_amdgcn_readfirstlane(tid >> 6), lane = tid & 63, wr = wid >> 2, wc = wid & 3, fr = lane & 15, fq = lane >> 4;
    const int K = g.K, nt = K / BK;
    unsigned voffA[2], voffB[2];
#pragma unroll
    for (int i = 0; i < 2; ++i) { int R, C; stage_rc(tid * 16 + i * 8192, R, C); const int Rb = Epi::PERM ? ((R & ~31) + perm32(R & 31)) : R;
        voffA[i] = (unsigned)(R * K + C) * 2u; voffB[i] = (unsigned)(Rb * K + C) * 2u; }
    const size_t kstep = (size_t)(BK * 2);
    const size_t hstep = (size_t)HALF * K * 2;
    const size_t tstep = 2 * hstep;
    const unsigned ldsw = (unsigned)wid * 1024u;
    const int aoff = lds_byte(wr * 64 + fr, fq * 8), boff = lds_byte(wc * 32 + fr, fq * 8);
#define PG8_SA(b, h) (((b) * 2 + (h)) * HTB)
#define PG8_SB(b, h) ((4 + (b) * 2 + (h)) * HTB)
#define PG8_STAGE(bufoff, gbase, voff) do { _Pragma("unroll") for (int _i = 0; _i < 2; ++_i) \
        __builtin_amdgcn_global_load_lds((const unsigned*)((const char*)(gbase) + (voff)[_i]), (PG8_LAS unsigned*)(lds + (bufoff) + ldsw + _i * 8192), 16, 0, 0); } while (0)
#define PG8_LDA(dst, b, h) do { _Pragma("unroll") for (int m = 0; m < 4; ++m) _Pragma("unroll") for (int k = 0; k < 2; ++k) dst[m][k] = *(const PG8_LAS bf16x8*)(lds + PG8_SA(b, h) + aoff + m * 2048 + k * 1024); } while (0)
#define PG8_LDB(dst, b, h) do { _Pragma("unroll") for (int n = 0; n < 2; ++n) _Pragma("unroll") for (int k = 0; k < 2; ++k) dst[n][k] = *(const PG8_LAS bf16x8*)(lds + PG8_SB(b, h) + boff + n * 2048 + k * 1024); } while (0)
#define PG8_MMA(ai, bj, At, Bt) do { __builtin_amdgcn_s_setprio(1); _Pragma("unroll") for (int m = 0; m < 4; ++m) _Pragma("unroll") for (int n = 0; n < 2; ++n) _Pragma("unroll") for (int k = 0; k < 2; ++k) \
        acc[ai][bj][m][n] = __builtin_amdgcn_mfma_f32_16x16x32_bf16(Bt[n][k], At[m][k], acc[ai][bj][m][n], 0, 0, 0); __builtin_amdgcn_s_setprio(0); } while (0)
#define PG8_WAIT_V(n) asm volatile("s_waitcnt vmcnt(" #n ")" ::: "memory")
#define PG8_WAIT_L(n) asm volatile("s_waitcnt lgkmcnt(" #n ")" ::: "memory")
#define PG8_BAR __builtin_amdgcn_s_barrier()
#define PG8_SCHED __builtin_amdgcn_sched_barrier(0)
    Unit cur, nxt; int ui = 0;
    if (!S.next(0, cur)) return;
    f32x4 acc[2][2][4][2];
#pragma unroll
    for (int a = 0; a < 2; ++a)
#pragma unroll
        for (int b = 0; b < 2; ++b)
#pragma unroll
            for (int m = 0; m < 4; ++m)
#pragma unroll
                for (int n = 0; n < 2; ++n) acc[a][b][m][n] = (f32x4){0.f, 0.f, 0.f, 0.f};
    bf16x8 At[4][2], B0[2][2], B1[2][2];
    const char* cA = (const char*)g.A + (size_t)cur.pm * tstep; const char* cB = (const char*)g.Bt + (size_t)cur.pn * tstep;
    S.a_ready(cur);
    if constexpr (SP2) {
        PG8_STAGE(PG8_SB(0, 0), cB, voffB); PG8_STAGE(PG8_SB(0, 1), cB + hstep, voffB); PG8_STAGE(PG8_SA(0, 0), cA, voffA); PG8_STAGE(PG8_SA(0, 1), cA + hstep, voffA);
        if (wr == 1) PG8_BAR;
        PG8_WAIT_V(2); PG8_BAR;
        PG8_STAGE(PG8_SB(1, 0), cB + kstep, voffB); PG8_STAGE(PG8_SA(1, 0), cA + kstep, voffA); PG8_STAGE(PG8_SB(1, 1), cB + hstep + kstep, voffB);
        PG8_WAIT_V(6); PG8_BAR;
    } else {
        PG8_STAGE(PG8_SB(0, 0), cB, voffB); PG8_STAGE(PG8_SA(0, 0), cA, voffA); PG8_STAGE(PG8_SB(0, 1), cB + hstep, voffB); PG8_STAGE(PG8_SA(0, 1), cA + hstep, voffA);
        if (wr == 1) PG8_BAR;
        PG8_WAIT_V(4); PG8_BAR;
        PG8_STAGE(PG8_SB(1, 0), cB + kstep, voffB); PG8_STAGE(PG8_SA(1, 0), cA + kstep, voffA); PG8_STAGE(PG8_SB(1, 1), cB + hstep + kstep, voffB);
        PG8_WAIT_V(6); PG8_BAR;
    }
    for (;;) {
        const bool has_next = S.next(ui + 1, nxt);
        const char* nA = has_next ? (const char*)g.A + (size_t)nxt.pm * tstep : cA; const char* nB = has_next ? (const char*)g.Bt + (size_t)nxt.pn * tstep : cB;
        for (int t = 0; t < nt; t += 2) {
            const bool last = (t == nt - 2);
            const char* a1 = cA + (size_t)(t + 1) * kstep;
            const char* a2 = last ? nA : cA + (size_t)(t + 2) * kstep; const char* b2 = last ? nB : cB + (size_t)(t + 2) * kstep;
            const char* a3 = a2 + kstep; const char* b3 = b2 + kstep;
            if (last && has_next) S.a_ready(nxt);
            if constexpr (SP2) {
            PG8_LDB(B0, 0, 0); PG8_LDB(B1, 0, 1); PG8_SCHED; PG8_LDA(At, 0, 0); PG8_STAGE(PG8_SA(1, 1), a1 + hstep, voffA);
            PG8_WAIT_V(8); PG8_WAIT_L(0); PG8_BAR; PG8_MMA(0, 0, At, B0); PG8_MMA(0, 1, At, B1); PG8_BAR; PG8_SCHED;
            PG8_LDA(At, 0, 1); PG8_STAGE(PG8_SB(0, 0), b2, voffB); PG8_STAGE(PG8_SB(0, 1), b2 + hstep, voffB); PG8_STAGE(PG8_SA(0, 0), a2, voffA);
            PG8_WAIT_V(8); PG8_WAIT_L(0); PG8_BAR; PG8_MMA(1, 0, At, B0); PG8_MMA(1, 1, At, B1); PG8_BAR; PG8_SCHED;
            PG8_LDB(B0, 1, 0); PG8_LDB(B1, 1, 1); PG8_SCHED; PG8_LDA(At, 1, 0); PG8_STAGE(PG8_SA(0, 1), a2 + hstep, voffA);
            PG8_WAIT_V(8); PG8_WAIT_L(0); PG8_BAR; PG8_MMA(0, 0, At, B0); PG8_MMA(0, 1, At, B1); PG8_BAR; PG8_SCHED;
            PG8_LDA(At, 1, 1); PG8_STAGE(PG8_SB(1, 0), b3, voffB); PG8_STAGE(PG8_SB(1, 1), b3 + hstep, voffB); PG8_STAGE(PG8_SA(1, 0), a3, voffA);
            PG8_WAIT_V(8); PG8_WAIT_L(0); PG8_BAR; PG8_MMA(1, 0, At, B0); PG8_MMA(1, 1, At, B1); PG8_BAR; PG8_SCHED;
            } else {
            PG8_LDB(B0, 0, 0); PG8_SCHED; PG8_LDA(At, 0, 0); PG8_STAGE(PG8_SA(1, 1), a1 + hstep, voffA);
            PG8_WAIT_L(8); PG8_BAR; PG8_WAIT_L(0); PG8_MMA(0, 0, At, B0); PG8_BAR; PG8_SCHED;
            PG8_LDB(B1, 0, 1); PG8_STAGE(PG8_SB(0, 0), b2, voffB);
            PG8_BAR; PG8_WAIT_L(0); PG8_MMA(0, 1, At, B1); PG8_BAR;
            PG8_LDA(At, 0, 1); PG8_STAGE(PG8_SA(0, 0), a2, voffA);
            PG8_BAR; PG8_WAIT_L(0); PG8_MMA(1, 0, At, B0); PG8_BAR; PG8_SCHED;
            PG8_STAGE(PG8_SB(0, 1), b2 + hstep, voffB);
            PG8_WAIT_V(6); PG8_BAR; PG8_MMA(1, 1, At, B1); PG8_BAR;
            PG8_LDB(B0, 1, 0); PG8_SCHED; PG8_LDA(At, 1, 0); PG8_STAGE(PG8_SA(0, 1), a2 + hstep, voffA);
            PG8_WAIT_L(8); PG8_BAR; PG8_WAIT_L(0); PG8_MMA(0, 0, At, B0); PG8_BAR; PG8_SCHED;
            PG8_LDB(B1, 1, 1); PG8_STAGE(PG8_SB(1, 0), b3, voffB);
            PG8_BAR; PG8_WAIT_L(0); PG8_MMA(0, 1, At, B1); PG8_BAR;
            PG8_LDA(At, 1, 1); PG8_STAGE(PG8_SA(1, 0), a3, voffA);
            PG8_BAR; PG8_WAIT_L(0); PG8_MMA(1, 0, At, B0); PG8_BAR; PG8_SCHED;
            PG8_STAGE(PG8_SB(1, 1), b3 + hstep, voffB);
            PG8_WAIT_V(6); PG8_BAR; PG8_MMA(1, 1, At, B1); PG8_BAR;
            }
        }
        if constexpr (ALIGN_EPI) { if (wr == 0) PG8_BAR; }
        if constexpr (!Epi::AFTER_DRAIN) { E(acc, cur, wr, wc, fr, fq); S.done(cur); }
        if (!has_next) break;
#pragma unroll
        for (int a = 0; a < 2; ++a)
#pragma unroll
            for (int b = 0; b < 2; ++b)
#pragma unroll
                for (int m = 0; m < 4; ++m)
#pragma unroll
                    for (int n = 0; n < 2; ++n) acc[a][b][m][n] = (f32x4){0.f, 0.f, 0.f, 0.f};
        cur = nxt; cA = nA; cB = nB; ++ui;
        if constexpr (ALIGN_EPI) { if (wr == 1) PG8_BAR; }
    }
    PG8_WAIT_V(0);
    if constexpr (!ALIGN_EPI) { if (wr == 0) PG8_BAR; }
    PG8_BAR;
    if constexpr (Epi::AFTER_DRAIN) { E.fused(acc, cur, wr, wc, fr, fq, lds, wid, lane); S.done(cur); }
#undef PG8_SA
#undef PG8_SB
#undef PG8_STAGE
#undef PG8_LDA
#undef PG8_LDB
#undef PG8_MMA
#undef PG8_WAIT_V
#undef PG8_WAIT_L
#undef PG8_BAR
#undef PG8_SCHED
}
}

#define PG8_SP2 true
#define PG8_ALIGN true
using pg8::bf16_t; using pg8::f32x4; using pg8::u32x4;
typedef unsigned u32x2 __attribute__((ext_vector_type(2)));

__device__ __forceinline__ float wave_sum(float v) {
#pragma unroll
    for (int o = 1; o < 64; o <<= 1) v += __shfl_xor(v, o);
    return v;
}
__device__ __forceinline__ float wave_max(float v) {
#pragma unroll
    for (int o = 1; o < 64; o <<= 1) v = fmaxf(v, __shfl_xor(v, o));
    return v;
}
__device__ __forceinline__ float silu_fast(float x) { return x * __builtin_amdgcn_rcpf(1.f + __builtin_amdgcn_exp2f(-1.4426950408889634f * x)); }
__device__ __forceinline__ float logsig_f(float x) { return fminf(x, 0.f) - log1pf(expf(-fabsf(x))); }
__device__ __forceinline__ void rope_cs(int pos, int i, float& c, float& s) {
    const float inv = exp2f(-(float)i * (13.287712379549449f / 32.f));
    double a = (double)pos * (double)inv;
    a -= 6.283185307179586 * floor(a * 0.15915494309189535);
    const float r = (float)a;
    c = cosf(r); s = sinf(r);
}
struct Rows2 { const float* a; const float* b; int split; int ld;
    __device__ __forceinline__ const float* row(int r) const { return r < split ? a + (size_t)r * ld : b + (size_t)(r - split) * ld; } };

__device__ __forceinline__ void rms_rows_1024(const Rows2 src, const float* w, float* dst, int nrows) {
    const int lane = threadIdx.x & 63, gw = blockIdx.x * (NTHR / 64) + (threadIdx.x >> 6), ngw = gridDim.x * (NTHR / 64);
    for (int r = gw; r < nrows; r += ngw) {
        const float4* p = (const float4*)src.row(r) + lane;
        float4 v[4]; float s = 0.f;
#pragma unroll
        for (int j = 0; j < 4; ++j) { v[j] = p[64 * j]; s += v[j].x * v[j].x + v[j].y * v[j].y + v[j].z * v[j].z + v[j].w * v[j].w; }
        const float rstd = 1.0f / sqrtf(wave_sum(s) * (1.f / 1024.f) + EPS);
        float4* o = (float4*)(dst + (size_t)r * DM) + lane;
#pragma unroll
        for (int j = 0; j < 4; ++j) { const float4 ww = ((const float4*)w)[lane + 64 * j]; float4 y; y.x = v[j].x * rstd * ww.x; y.y = v[j].y * rstd * ww.y; y.z = v[j].z * rstd * ww.z; y.w = v[j].w * rstd * ww.w; o[64 * j] = y; }
    }
}

constexpr int RSTAB_OFF = 131072 + 6144;
struct RsTab { int p0, p1, p2, p3; const LAS float* tab; };
__device__ __forceinline__ float rstd_from(const float* ssq, int nslot, int row);
__device__ __forceinline__ float rstab_get(const RsTab& T, const float* slots, int pm, int rit) {
    const int s = pm == T.p0 ? 0 : (pm == T.p1 ? 1 : (pm == T.p2 ? 2 : (pm == T.p3 ? 3 : -1)));
    return s >= 0 ? T.tab[s * 256 + rit] : rstd_from(slots, 16, pm * 256 + rit);
}
__device__ __forceinline__ float rstd_from(const float* ssq, int nslot, int row) {
    float s;
    if (nslot == 1) s = ssq[row];
    else { const f32x4* p = (const f32x4*)(ssq + (size_t)row * 16); const f32x4 a = p[0], b = p[1], c = p[2], d = p[3];
        s = (((a[0] + a[1]) + (a[2] + a[3])) + ((b[0] + b[1]) + (b[2] + b[3]))) + (((c[0] + c[1]) + (c[2] + c[3])) + ((d[0] + d[1]) + (d[2] + d[3]))); }
    return 1.0f / sqrtf(s * (1.f / 1024.f) + EPS);
}
template <bool HAS_RS> struct EpiSwigluB { static constexpr bool PERM = true, AFTER_DRAIN = false;
    bf16_t* H; const float* ssq; int nslot; RsTab T;
    __device__ __forceinline__ void operator()(const f32x4 (&acc)[2][2][4][2], const pg8::Unit& u, int wr, int wc, int fr, int fq) const {
        const int row0 = u.pm * 256 + wr * 64 + fr, col0 = u.pn * 128 + wc * 32 + 8 * fq;
#pragma unroll
        for (int ai = 0; ai < 2; ++ai)
#pragma unroll
            for (int m = 0; m < 4; ++m) { const int row = row0 + ai * 128 + m * 16; const float rs = HAS_RS ? rstab_get(T, ssq, u.pm, wr * 64 + fr + ai * 128 + m * 16) : 1.0f;
                const f32x4 g0 = acc[ai][0][m][0] * rs, g1 = acc[ai][0][m][1] * rs, u0 = acc[ai][1][m][0] * rs, u1 = acc[ai][1][m][1] * rs;
                u32x4 w;
                w.x = pg8::cvt_pk_bf16(silu_fast(g0[0]) * u0[0], silu_fast(g0[1]) * u0[1]); w.y = pg8::cvt_pk_bf16(silu_fast(g0[2]) * u0[2], silu_fast(g0[3]) * u0[3]);
                w.z = pg8::cvt_pk_bf16(silu_fast(g1[0]) * u1[0], silu_fast(g1[1]) * u1[1]); w.w = pg8::cvt_pk_bf16(silu_fast(g1[2]) * u1[2], silu_fast(g1[3]) * u1[3]);
                *(u32x4*)(H + (size_t)row * DFF + col0) = w; }
    }
};
template <bool BASE_BF16> struct EpiResidB { static constexpr bool PERM = true, AFTER_DRAIN = false;
    const float* basef; const bf16_t* baseb; bf16_t* outb; float* slots; float scale;
    __device__ __forceinline__ void operator()(const f32x4 (&acc)[2][2][4][2], const pg8::Unit& u, int wr, int wc, int fr, int fq) const {
        const int row0 = u.pm * 256 + wr * 64 + fr, col0 = u.pn * 256 + wc * 32 + 8 * fq;
#pragma unroll
        for (int ai = 0; ai < 2; ++ai) {
            f32x4 pf[4][2][2]; u32x4 pb[4][2];
#pragma unroll
            for (int m = 0; m < 4; ++m) { const size_t ro = (size_t)(row0 + ai * 128 + m * 16) * DM + col0;
#pragma unroll
                for (int bj = 0; bj < 2; ++bj) { if (BASE_BF16) pb[m][bj] = *(const u32x4*)(baseb + ro + bj * 128); else { pf[m][bj][0] = *(const f32x4*)(basef + ro + bj * 128); pf[m][bj][1] = *(const f32x4*)(basef + ro + bj * 128 + 4); } } }
            __builtin_amdgcn_sched_barrier(0);
#pragma unroll
            for (int m = 0; m < 4; ++m) { const int row = row0 + ai * 128 + m * 16; bf16_t* ob = outb + (size_t)row * DM + col0;
                float ss = 0.f;
#pragma unroll
                for (int bj = 0; bj < 2; ++bj) { f32x4 b0, b1;
                    if (BASE_BF16) { const u32x4 r = pb[m][bj];
                        b0 = (f32x4){__uint_as_float(r.x << 16), __uint_as_float(r.x & 0xffff0000u), __uint_as_float(r.y << 16), __uint_as_float(r.y & 0xffff0000u)};
                        b1 = (f32x4){__uint_as_float(r.z << 16), __uint_as_float(r.z & 0xffff0000u), __uint_as_float(r.w << 16), __uint_as_float(r.w & 0xffff0000u)}; }
                    else { b0 = pf[m][bj][0]; b1 = pf[m][bj][1]; }
                    const f32x4 o0 = b0 + acc[ai][bj][m][0] * scale, o1 = b1 + acc[ai][bj][m][1] * scale;
                    ss += ((o0[0] * o0[0] + o0[1] * o0[1]) + (o0[2] * o0[2] + o0[3] * o0[3])) + ((o1[0] * o1[0] + o1[1] * o1[1]) + (o1[2] * o1[2] + o1[3] * o1[3]));
                    u32x4 w; w.x = pg8::cvt_pk_bf16(o0[0], o0[1]); w.y = pg8::cvt_pk_bf16(o0[2], o0[3]); w.z = pg8::cvt_pk_bf16(o1[0], o1[1]); w.w = pg8::cvt_pk_bf16(o1[2], o1[3]);
                    *(u32x4*)(ob + bj * 128) = w; }
                ss += __shfl_xor(ss, 16); ss += __shfl_xor(ss, 32);
                if (fq == 0) slots[(size_t)row * 16 + u.pn * 4 + wc] = ss; } }
    }
};
struct EpiProj2 { static constexpr bool PERM = false, AFTER_DRAIN = false;
    float* PROJ; const float* slots; RsTab T; bf16_t* CQB; float* CQS; float* CKV; float* KPR; bf16_t* QG; bf16_t* KG; bf16_t* VT; float* VS; bf16_t* SG; float* ALOW;
    __device__ __forceinline__ void operator()(const f32x4 (&acc)[2][2][4][2], const pg8::Unit& u, int wr, int wc, int fr, int fq) const {
        const int row0 = u.pm * 256 + wr * 64 + fr, col0 = u.pn * 256 + wc * 32 + 4 * fq;
#pragma unroll
        for (int ai = 0; ai < 2; ++ai) { if (u.pm == PAD_PM && ai == 1) continue;
#pragma unroll
            for (int m = 0; m < 4; ++m) { const int row = row0 + ai * 128 + m * 16; const float rs = rstab_get(T, slots, u.pm, wr * 64 + fr + ai * 128 + m * 16);
                float ss = 0.f;
#pragma unroll
                for (int bj = 0; bj < 2; ++bj)
#pragma unroll
                    for (int n = 0; n < 2; ++n) { const int c = col0 + bj * 128 + n * 16; const f32x4 v = acc[ai][bj][m][n] * rs;
                        if (u.pn == 0) { u32x2 w; w.x = pg8::cvt_pk_bf16(v[0] * 0.125f, v[1] * 0.125f); w.y = pg8::cvt_pk_bf16(v[2] * 0.125f, v[3] * 0.125f); *(u32x2*)(QG + (size_t)row * 256 + c) = w; }
                        if (u.pn == 1) { u32x2 w; w.x = pg8::cvt_pk_bf16(v[0], v[1]); w.y = pg8::cvt_pk_bf16(v[2], v[3]); *(u32x2*)(KG + (size_t)row * 256 + (c - 256)) = w; }
                        if (u.pn == 4 || u.pn == 5) { u32x2 w; w.x = pg8::cvt_pk_bf16(silu_fast(v[0]), silu_fast(v[1])); w.y = pg8::cvt_pk_bf16(silu_fast(v[2]), silu_fast(v[3])); *(u32x2*)(SG + (size_t)row * 512 + (c - 1024)) = w; }
                        if (u.pn == 6) { u32x2 w; w.x = pg8::cvt_pk_bf16(v[0], v[1]); w.y = pg8::cvt_pk_bf16(v[2], v[3]); *(u32x2*)(CQB + (size_t)row * 256 + (c - 1536)) = w;
                            ss += (v[0] * v[0] + v[1] * v[1]) + (v[2] * v[2] + v[3] * v[3]); }
                        if (u.pn == 7) { const int cc = c - 1792;
                            if (cc < 128) *(f32x4*)(CKV + (size_t)row * 128 + cc) = v;
                            else if (cc < 192) *(f32x4*)(KPR + (size_t)row * 64 + (cc - 128)) = v;
                            else if (cc < 208) *(f32x4*)(ALOW + (size_t)row * 16 + (cc - 192)) = v; } }
                if (u.pn == 6) { ss += __shfl_xor(ss, 16); ss += __shfl_xor(ss, 32); if (fq == 0) CQS[(size_t)row * 4 + wc] = ss; } } }
    }
};
constexpr float QSCALE = 0.07216878364870322f * 1.4426950408889634f;
struct EpiQabs { static constexpr bool PERM = true, AFTER_DRAIN = false;
    bf16_t* QA; const float* CQS; const float2* RT;
    __device__ __forceinline__ void operator()(const f32x4 (&acc)[2][2][4][2], const pg8::Unit& u, int wr, int wc, int fr, int fq) const {
        const int row0 = u.pm * 256 + wr * 64 + fr, colt = wc * 32 + 8 * fq;
#pragma unroll
        for (int ai = 0; ai < 2; ++ai) { if (u.pm == PAD_PM && ai == 1) continue;
#pragma unroll
            for (int m = 0; m < 4; ++m) { const int row = row0 + ai * 128 + m * 16; const f32x4 sl = *(const f32x4*)(CQS + (size_t)row * 4);
                const float rq = QSCALE / sqrtf(((sl[0] + sl[1]) + (sl[2] + sl[3])) * (1.f / 256.f) + EPS);
#pragma unroll
                for (int bj = 0; bj < 2; ++bj) { const f32x4 v0 = acc[ai][bj][m][0] * rq, v1 = acc[ai][bj][m][1] * rq; const int cc = bj * 128 + colt;
                    u32x4 w; w.x = pg8::cvt_pk_bf16(v0[0], v0[1]); w.y = pg8::cvt_pk_bf16(v0[2], v0[3]); w.z = pg8::cvt_pk_bf16(v1[0], v1[1]); w.w = pg8::cvt_pk_bf16(v1[2], v1[3]);
                    *(u32x4*)(QA + (size_t)row * 768 + u.pn * 256 + cc) = w; } } }
    }
};

typedef short bf16x8 __attribute__((ext_vector_type(8)));
typedef float f32x16 __attribute__((ext_vector_type(16)));
typedef short s16x4 __attribute__((ext_vector_type(4)));
typedef float f32x2_t __attribute__((ext_vector_type(2))); typedef __bf16 bf16x2_t __attribute__((ext_vector_type(2)));
__device__ __forceinline__ unsigned cvtpk_s(float lo, float hi) { f32x2_t v = {lo, hi}; bf16x2_t b = __builtin_convertvector(v, bf16x2_t); return __builtin_bit_cast(unsigned, b); }
__device__ __forceinline__ s16x4 vtr(const LAS unsigned char* p) { return __builtin_bit_cast(s16x4, __builtin_amdgcn_ds_read_tr16_b64_v4i16((LAS s16x4*)p)); }
__device__ __forceinline__ int crow(int r, int hi) { return (r & 3) + 8 * (r >> 2) + 4 * hi; }
constexpr int AT_ROWB = 400, AT_BUF = 64 * AT_ROWB;
__device__ __forceinline__ void mla_attn_unit(LAS unsigned char* ldsl, const bf16_t* QA, const bf16_t* KL, const float2* RT, bf16_t* YMIXB, int b, int qb, int tid, int lane, int wave) {
    const int hh = wave >> 1, qs = wave & 1, r32 = lane & 31, hi = lane >> 5;
    const int qpos = qb * 64 + qs * 32 + r32; const size_t qrow = (size_t)b * SEQ + qpos;
    bf16x8 qf[12];
#pragma unroll
    for (int ks = 0; ks < 8; ++ks) qf[ks] = *(const bf16x8*)(QA + qrow * 768 + hh * 128 + 16 * ks + 8 * hi);
#pragma unroll
    for (int ks = 0; ks < 4; ++ks) {
        const u32x4 raw = *(const u32x4*)(QA + qrow * 768 + 512 + hh * 64 + 16 * ks + 8 * hi);
        const f32x4* rp = (const f32x4*)(RT + (size_t)qpos * 32 + 8 * ks + 4 * hi); const f32x4 t0 = rp[0], t1 = rp[1];
        u32x4 w;
        { const float x1 = __uint_as_float(raw.x << 16), x2 = __uint_as_float(raw.x & 0xffff0000u); w.x = cvtpk_s(x1 * t0[0] - x2 * t0[1], x1 * t0[1] + x2 * t0[0]); }
        { const float x1 = __uint_as_float(raw.y << 16), x2 = __uint_as_float(raw.y & 0xffff0000u); w.y = cvtpk_s(x1 * t0[2] - x2 * t0[3], x1 * t0[3] + x2 * t0[2]); }
        { const float x1 = __uint_as_float(raw.z << 16), x2 = __uint_as_float(raw.z & 0xffff0000u); w.z = cvtpk_s(x1 * t1[0] - x2 * t1[1], x1 * t1[1] + x2 * t1[0]); }
        { const float x1 = __uint_as_float(raw.w << 16), x2 = __uint_as_float(raw.w & 0xffff0000u); w.w = cvtpk_s(x1 * t1[2] - x2 * t1[3], x1 * t1[3] + x2 * t1[2]); }
        qf[8 + ks] = __builtin_bit_cast(bf16x8, w); }
    f32x16 o[4];
#pragma unroll
    for (int d = 0; d < 4; ++d)
#pragma unroll
        for (int r = 0; r < 16; ++r) o[d][r] = 0.f;
    float mrun = -1e30f, lrun = 0.f;
    const int nt = qb + 1;
    const unsigned char* kg = (const unsigned char*)(KL + (size_t)b * SEQ * 192);
    u32x4 stg[3];
#pragma unroll
    for (int i = 0; i < 3; ++i) stg[i] = *(const u32x4*)(kg + (size_t)(tid + 512 * i) * 16);
#pragma unroll
    for (int i = 0; i < 3; ++i) { const int c = tid + 512 * i, row = c / 24, col = c - row * 24; *(LAS u32x4*)(ldsl + row * AT_ROWB + col * 16) = stg[i]; }
    __syncthreads();
    const int blk = (lane >> 4) & 1, q4 = (lane & 15) >> 2, p4 = lane & 3;
    const bool gB = wave >= 4;
#define AT_LOADT(tt) _Pragma("unroll") for (int i = 0; i < 3; ++i) stg[i] = *(const u32x4*)(kg + (size_t)(tt) * 24576 + (size_t)(tid + 512 * i) * 16);
#define AT_WRITET(tt) _Pragma("unroll") for (int i = 0; i < 3; ++i) { const int c = tid + 512 * i, row = c / 24, col = c - row * 24; *(LAS u32x4*)(ldsl + ((tt) & 1) * AT_BUF + row * AT_ROWB + col * 16) = stg[i]; }
    if (gB) { if (nt > 1) { AT_LOADT(1) } __syncthreads(); }
    for (int t = 0; t < nt; ++t) {
        const LAS unsigned char* kb = ldsl + (t & 1) * AT_BUF;
        if (!gB && t + 1 < nt) { AT_LOADT(t + 1) }
        f32x16 s0, s1;
#pragma unroll
        for (int r = 0; r < 16; ++r) { s0[r] = 0.f; s1[r] = 0.f; }
#pragma unroll
        for (int ks = 0; ks < 12; ++ks) {
            const bf16x8 k0 = *(const LAS bf16x8*)(kb + r32 * AT_ROWB + 32 * ks + 16 * hi);
            const bf16x8 k1 = *(const LAS bf16x8*)(kb + (32 + r32) * AT_ROWB + 32 * ks + 16 * hi);
            s0 = __builtin_amdgcn_mfma_f32_32x32x16_bf16(k0, qf[ks], s0, 0, 0, 0);
            s1 = __builtin_amdgcn_mfma_f32_32x32x16_bf16(k1, qf[ks], s1, 0, 0, 0);
        }
        if (gB && t + 1 < nt) { AT_WRITET(t + 1) }
        __syncthreads();
        if (gB && t + 2 < nt) { AT_LOADT(t + 2) }
        if (t == qb) {
#pragma unroll
            for (int r = 0; r < 16; ++r) { const int kv = t * 64 + crow(r, hi); if (kv > qpos) s0[r] = -INFINITY; if (kv + 32 > qpos) s1[r] = -INFINITY; }
        }
        float mx = fmaxf(s0[0], s1[0]);
#pragma unroll
        for (int r = 1; r < 16; ++r) mx = fmaxf(mx, fmaxf(s0[r], s1[r]));
        mx = fmaxf(mx, __shfl_xor(mx, 32));
        const float mn = fmaxf(mrun, mx), alpha = __builtin_amdgcn_exp2f(mrun - mn);
        float ps = 0.f;
#pragma unroll
        for (int r = 0; r < 16; ++r) { s0[r] = __builtin_amdgcn_exp2f(s0[r] - mn); s1[r] = __builtin_amdgcn_exp2f(s1[r] - mn); ps += s0[r] + s1[r]; }
        lrun = lrun * alpha + ps; mrun = mn;
        if (__any(alpha != 1.0f)) {
#pragma unroll
            for (int d = 0; d < 4; ++d)
#pragma unroll
                for (int r = 0; r < 16; ++r) o[d][r] *= alpha; }
        bf16x8 pf[4];
#pragma unroll
        for (int s = 0; s < 2; ++s) {
            u32x4 w0, w1;
            w0.x = cvtpk_s(s0[8 * s + 0], s0[8 * s + 1]); w0.y = cvtpk_s(s0[8 * s + 2], s0[8 * s + 3]); w0.z = cvtpk_s(s0[8 * s + 4], s0[8 * s + 5]); w0.w = cvtpk_s(s0[8 * s + 6], s0[8 * s + 7]);
            w1.x = cvtpk_s(s1[8 * s + 0], s1[8 * s + 1]); w1.y = cvtpk_s(s1[8 * s + 2], s1[8 * s + 3]); w1.z = cvtpk_s(s1[8 * s + 4], s1[8 * s + 5]); w1.w = cvtpk_s(s1[8 * s + 6], s1[8 * s + 7]);
            pf[s] = __builtin_bit_cast(bf16x8, w0); pf[2 + s] = __builtin_bit_cast(bf16x8, w1);
        }
#pragma unroll
        for (int kk = 0; kk < 4; ++kk)
#pragma unroll
            for (int d = 0; d < 4; ++d) {
                const int R = 32 * (kk >> 1) + 16 * (kk & 1) + 4 * hi;
                const LAS unsigned char* vp = kb + (R + q4) * AT_ROWB + (32 * d + 16 * blk) * 2 + 8 * p4;
                const s16x4 lo = vtr(vp), hi4 = vtr(vp + 8 * AT_ROWB);
                const bf16x8 vf = (bf16x8){lo[0], lo[1], lo[2], lo[3], hi4[0], hi4[1], hi4[2], hi4[3]};
                o[d] = __builtin_amdgcn_mfma_f32_32x32x16_bf16(vf, pf[kk], o[d], 0, 0, 0);
            }
        if (!gB && t + 1 < nt) { AT_WRITET(t + 1) }
        __syncthreads();
    }
    if (!gB) __syncthreads();
#undef AT_LOADT
#undef AT_WRITET
    const float il = 1.0f / (lrun + __shfl_xor(lrun, 32));
#pragma unroll
    for (int d = 0; d < 4; ++d)
#pragma unroll
        for (int g4 = 0; g4 < 4; ++g4) { u32x2 w; w.x = cvtpk_s(o[d][4 * g4] * il, o[d][4 * g4 + 1] * il); w.y = cvtpk_s(o[d][4 * g4 + 2] * il, o[d][4 * g4 + 3] * il);
            *(u32x2*)(YMIXB + qrow * DM + 512 + hh * 128 + 32 * d + 8 * g4 + 4 * hi) = w; }
}

__device__ __forceinline__ float bf2f(bf16_t x) { return __uint_as_float((unsigned)x << 16); }
constexpr int KTT_PITCH = 144, KTT_BYTES = 64 * KTT_PITCH;
__device__ __forceinline__ void gla_prep_unit(LAS unsigned char* ktt, bf16_t* QG, bf16_t* KG, const float* ALOW, const float* w_a_up, const float* b_a, const bf16_t* VT, float* DEC, bf16_t* UT, int u, int lane) {
    const int c = u & 31, bh = u >> 5, h = bh & 3, b = bh >> 2;
    const size_t row0 = (size_t)b * SEQ + c * 64;
    const int d = lane;
    float wa[16];
#pragma unroll
    for (int r = 0; r < 16; ++r) wa[r] = w_a_up[r * 256 + h * 64 + d];
    const float ba = b_a[h * 64 + d];
    float bsum = 0.f;
#pragma unroll 8
    for (int t = 0; t < 64; ++t) {
        const size_t row = row0 + t;
        const f32x4* ap = (const f32x4*)(ALOW + row * 16); const f32x4 a0 = ap[0], a1 = ap[1], a2 = ap[2], a3 = ap[3];
        float x = ba;
        x += a0[0] * wa[0]; x += a0[1] * wa[1]; x += a0[2] * wa[2]; x += a0[3] * wa[3]; x += a1[0] * wa[4]; x += a1[1] * wa[5]; x += a1[2] * wa[6]; x += a1[3] * wa[7];
        x += a2[0] * wa[8]; x += a2[1] * wa[9]; x += a2[2] * wa[10]; x += a2[3] * wa[11]; x += a3[0] * wa[12]; x += a3[1] * wa[13]; x += a3[2] * wa[14]; x += a3[3] * wa[15];
        const float l2 = (fminf(x, 0.f) * 1.4426950408889634f - __builtin_amdgcn_logf(1.f + __builtin_amdgcn_exp2f(-fabsf(x) * 1.4426950408889634f))) * (1.f / 16.f);
        bsum += l2;
        const float eb = __builtin_amdgcn_exp2f(bsum), enb = __builtin_amdgcn_exp2f(-bsum);
        const size_t off = row * 256 + h * 64 + d;
        const float q = bf2f(QG[off]), k = bf2f(KG[off]);
        const unsigned pk = pg8::cvt_pk_bf16(q * eb, k * enb);
        QG[off] = (bf16_t)(pk & 0xffffu); KG[off] = (bf16_t)(pk >> 16);
        *(LAS bf16_t*)(ktt + d * KTT_PITCH + t * 2) = (bf16_t)(pk >> 16);
    }
    DEC[(size_t)u * 64 + d] = __builtin_amdgcn_exp2f(bsum);
    asm volatile("s_waitcnt lgkmcnt(0)" ::: "memory");
    const int r32 = lane & 31, hi = lane >> 5;
    bf16x8 kf[2][4];
#pragma unroll
    for (int db = 0; db < 2; ++db)
#pragma unroll
        for (int s = 0; s < 4; ++s) kf[db][s] = *(const LAS bf16x8*)(ktt + (32 * db + r32) * KTT_PITCH + (16 * s + 8 * hi) * 2);
    const bf16_t* vt = VT + ((size_t)(bh * 128)) * 2048 + c * 64;
#pragma unroll
    for (int vb = 0; vb < 4; ++vb) {
        bf16x8 vf[4];
#pragma unroll
        for (int s = 0; s < 4; ++s) vf[s] = *(const bf16x8*)(vt + (size_t)(32 * vb + r32) * 2048 + 16 * s + 8 * hi);
#pragma unroll
        for (int db = 0; db < 2; ++db) {
            f32x16 acc;
#pragma unroll
            for (int r = 0; r < 16; ++r) acc[r] = 0.f;
#pragma unroll
            for (int s = 0; s < 4; ++s) acc = __builtin_amdgcn_mfma_f32_32x32x16_bf16(vf[s], kf[db][s], acc, 0, 0, 0);
#pragma unroll
            for (int r = 0; r < 16; ++r) UT[((size_t)u * 128 + 32 * vb + crow(r, hi)) * 64 + 32 * db + r32] = (bf16_t)(cvtpk_s(acc[r], 0.f) & 0xffffu);
        }
    }
    asm volatile("s_waitcnt lgkmcnt(0)" ::: "memory");
}
constexpr int GD_PITCH = 132, GD_BYTES = 32 * GD_PITCH * 4;
__device__ __forceinline__ void gla_out_unit(LAS unsigned char* wl, const bf16_t* QT, const bf16_t* KT, const bf16_t* VT, const bf16_t* ST, const bf16_t* SG, const float* gnw, bf16_t* YMIXB, int u, int lane) {
    const int ib = u & 1, c = (u >> 1) & 31, bh = u >> 6, h = bh & 3, b = bh >> 2;
    const size_t row0 = (size_t)b * SEQ + c * 64;
    const int r32 = lane & 31, hi = lane >> 5;
    const size_t row = row0 + 32 * ib + r32;
    bf16x8 qb[4], sf[4][4], kf[2][4];
#pragma unroll
    for (int s = 0; s < 4; ++s) qb[s] = *(const bf16x8*)(QT + row * 256 + h * 64 + 16 * s + 8 * hi);
    const bf16_t* st = ST + (size_t)(bh * 32 + c) * 128 * 64;
#pragma unroll
    for (int vb = 0; vb < 4; ++vb)
#pragma unroll
        for (int s = 0; s < 4; ++s) sf[vb][s] = *(const bf16x8*)(st + (size_t)(32 * vb + r32) * 64 + 16 * s + 8 * hi);
#pragma unroll
    for (int jb = 0; jb < 2; ++jb)
#pragma unroll
        for (int s = 0; s < 4; ++s) kf[jb][s] = *(const bf16x8*)(KT + (row0 + 32 * (jb <= ib ? jb : 0) + r32) * 256 + h * 64 + 16 * s + 8 * hi);
    __builtin_amdgcn_sched_barrier(0);
    f32x16 o[4];
#pragma unroll
    for (int vb = 0; vb < 4; ++vb) {
#pragma unroll
        for (int r = 0; r < 16; ++r) o[vb][r] = 0.f;
#pragma unroll
        for (int s = 0; s < 4; ++s) o[vb] = __builtin_amdgcn_mfma_f32_32x32x16_bf16(sf[vb][s], qb[s], o[vb], 0, 0, 0); }
    const bf16_t* vt = VT + ((size_t)(bh * 128)) * 2048 + c * 64;
    u32x4 vv[2][2][4];
#pragma unroll
    for (int jb = 0; jb < 2; ++jb)
#pragma unroll
        for (int s2 = 0; s2 < 2; ++s2)
#pragma unroll
            for (int vb = 0; vb < 4; ++vb) { const bf16_t* vp = vt + (size_t)(32 * vb + r32) * 2048 + 32 * (jb <= ib ? jb : 0) + 16 * s2 + 8 * hi;
                const u32x4 raw = *(const u32x4*)vp;
                const auto s0_ = __builtin_amdgcn_permlane32_swap(raw.x, raw.z, false, false); const auto s1_ = __builtin_amdgcn_permlane32_swap(raw.y, raw.w, false, false);
                vv[jb][s2][vb] = (u32x4){s0_[0], s1_[0], s0_[1], s1_[1]}; }
    __builtin_amdgcn_sched_barrier(0);
#pragma unroll
    for (int jb = 0; jb < 2; ++jb) {
        if (jb <= ib) {
            f32x16 x;
#pragma unroll
            for (int r = 0; r < 16; ++r) x[r] = 0.f;
#pragma unroll
            for (int s = 0; s < 4; ++s) x = __builtin_amdgcn_mfma_f32_32x32x16_bf16(kf[jb][s], qb[s], x, 0, 0, 0);
            if (jb == ib) {
#pragma unroll
                for (int r = 0; r < 16; ++r) if (crow(r, hi) > r32) x[r] = 0.f; }
#pragma unroll
            for (int s2 = 0; s2 < 2; ++s2) {
                u32x4 w; w.x = cvtpk_s(x[8 * s2 + 0], x[8 * s2 + 1]); w.y = cvtpk_s(x[8 * s2 + 2], x[8 * s2 + 3]); w.z = cvtpk_s(x[8 * s2 + 4], x[8 * s2 + 5]); w.w = cvtpk_s(x[8 * s2 + 6], x[8 * s2 + 7]);
                const bf16x8 pf = __builtin_bit_cast(bf16x8, w);
#pragma unroll
                for (int vb = 0; vb < 4; ++vb) o[vb] = __builtin_amdgcn_mfma_f32_32x32x16_bf16(__builtin_bit_cast(bf16x8, vv[jb][s2][vb]), pf, o[vb], 0, 0, 0);
            }
        }
    }
    float ss = 0.f;
#pragma unroll
    for (int vb = 0; vb < 4; ++vb)
#pragma unroll
        for (int r = 0; r < 16; ++r) ss += o[vb][r] * o[vb][r];
    ss += __shfl_xor(ss, 32);
    u32x4 sgp[8];
#pragma unroll
    for (int k = 0; k < 8; ++k) { const int p = lane + 64 * k; sgp[k] = *(const u32x4*)(SG + (row0 + 32 * ib + (p >> 4)) * 512 + h * 128 + 8 * (p & 15)); }
    const float rstd = 1.0f / sqrtf(ss * (1.f / 128.f) + EPS);
    LAS float* tl = (LAS float*)wl;
#pragma unroll
    for (int vb = 0; vb < 4; ++vb)
#pragma unroll
        for (int g4 = 0; g4 < 4; ++g4) *(LAS f32x4*)(tl + r32 * GD_PITCH + 32 * vb + 8 * g4 + 4 * hi) = (f32x4){o[vb][4 * g4 + 0] * rstd, o[vb][4 * g4 + 1] * rstd, o[vb][4 * g4 + 2] * rstd, o[vb][4 * g4 + 3] * rstd};
    asm volatile("s_waitcnt lgkmcnt(0)" ::: "memory");
#pragma unroll
    for (int k = 0; k < 8; ++k) { const int p = lane + 64 * k, tok = p >> 4, v8 = 8 * (p & 15);
        const f32x4 a = *(const LAS f32x4*)(tl + tok * GD_PITCH + v8), b2 = *(const LAS f32x4*)(tl + tok * GD_PITCH + v8 + 4);
        const f32x4 g0 = *(const f32x4*)(gnw + v8), g1 = *(const f32x4*)(gnw + v8 + 4); const u32x4 sgv = sgp[k];
        u32x4 w;
        w.x = cvtpk_s(a[0] * g0[0] * __uint_as_float(sgv.x << 16), a[1] * g0[1] * __uint_as_float(sgv.x & 0xffff0000u));
        w.y = cvtpk_s(a[2] * g0[2] * __uint_as_float(sgv.y << 16), a[3] * g0[3] * __uint_as_float(sgv.y & 0xffff0000u));
        w.z = cvtpk_s(b2[0] * g1[0] * __uint_as_float(sgv.z << 16), b2[1] * g1[1] * __uint_as_float(sgv.z & 0xffff0000u));
        w.w = cvtpk_s(b2[2] * g1[2] * __uint_as_float(sgv.w << 16), b2[3] * g1[3] * __uint_as_float(sgv.w & 0xffff0000u));
        *(u32x4*)(YMIXB + (row0 + 32 * ib + tok) * DM + h * 128 + v8) = w; }
    asm volatile("s_waitcnt lgkmcnt(0)" ::: "memory");
}

constexpr int DQ_BYTES = 32 * AT_ROWB;
__device__ __forceinline__ void decode_item_mfma(LAS unsigned char* ldsl, const bf16_t* QA, const float2* RT, const float* cache_kv, const float* cache_pe, const int* page_table, float* PART, int item, int tid, int lane, int wave) {
    const int bs = item >> 1, half = item & 1, r32 = lane & 31, hi = lane >> 5;
    const size_t qrow = (size_t)(MP + bs);
    __syncthreads();
#pragma unroll 1
    for (int e = 100 + tid; e < 32 * AT_ROWB / 16; e += 512) *(LAS u32x4*)(ldsl + e * 16) = (u32x4){0u, 0u, 0u, 0u};
#pragma unroll 1
    for (int e = tid; e < 768; e += 512) { const int row = e >= 576 ? 3 : (e >= 384 ? 2 : (e >= 192 ? 1 : 0)), col = e - 192 * row; float v;
        if (col < 128) v = bf2f(QA[qrow * 768 + row * 128 + col]);
        else { const int n = col - 128, ii = n & 31; const unsigned pr = *(const unsigned*)(QA + qrow * 768 + 512 + row * 64 + 2 * ii);
            const float x1 = __uint_as_float(pr << 16), x2 = __uint_as_float(pr & 0xffff0000u); const float2 cs = RT[(size_t)SEQ * 32 + ii]; v = n < 32 ? x1 * cs.x - x2 * cs.y : x1 * cs.y + x2 * cs.x; }
        *(LAS bf16_t*)(ldsl + row * AT_ROWB + col * 2) = (bf16_t)(cvtpk_s(v, 0.f) & 0xffffu); }
    if (tid < 4) { *(LAS u32x4*)(ldsl + tid * AT_ROWB + 384) = (u32x4){0u, 0u, 0u, 0u}; }
    __syncthreads();
    LAS unsigned char* kt = ldsl + (1 + wave) * DQ_BYTES;
    const int ptv = page_table[bs * NPAGES + half * 32 + r32];
    f32x16 o[4];
#pragma unroll
    for (int d = 0; d < 4; ++d)
#pragma unroll
        for (int r = 0; r < 16; ++r) o[d][r] = 0.f;
    float mrun = -1e30f, lrun = 0.f;
    const int blk = (lane >> 4) & 1, q4 = (lane & 15) >> 2, p4 = lane & 3;
    f32x4 sl[16], sp[8];
    const __amdgpu_buffer_rsrc_t rkv = __builtin_amdgcn_make_buffer_rsrc((void*)cache_kv, 0, 0x7fffffff, 0x00020000);
    const __amdgpu_buffer_rsrc_t rpe = __builtin_amdgcn_make_buffer_rsrc((void*)cache_pe, 0, 0x7fffffff, 0x00020000);
    const int lo16 = lane * 16;
#define DM_LOAD(kbi) { const int j0_ = 32 * (kbi); const int pg_ = __builtin_amdgcn_readlane(ptv, j0_ >> 7); const int r0_ = pg_ * PAGE + (j0_ & 127); \
        _Pragma("unroll") for (int c_ = 0; c_ < 16; ++c_) sl[c_] = __builtin_bit_cast(f32x4, __builtin_amdgcn_raw_buffer_load_b128(rkv, lo16, r0_ * 512 + 1024 * c_, 2)); \
        _Pragma("unroll") for (int c_ = 0; c_ < 8; ++c_) sp[c_] = __builtin_bit_cast(f32x4, __builtin_amdgcn_raw_buffer_load_b128(rpe, lo16, r0_ * 256 + 1024 * c_, 2)); }
    DM_LOAD(wave)
    for (int i = 0; i < 16; ++i) {
#pragma unroll
        for (int c = 0; c < 16; ++c) { const int ch = lane + 64 * c, row = ch >> 5, col4 = ch & 31; u32x2 w; w.x = cvtpk_s(sl[c][0], sl[c][1]); w.y = cvtpk_s(sl[c][2], sl[c][3]); *(LAS u32x2*)(kt + row * AT_ROWB + col4 * 8) = w; }
#pragma unroll
        for (int c = 0; c < 8; ++c) { const int ch = lane + 64 * c, row = ch >> 4, col4 = ch & 15; u32x2 w; w.x = cvtpk_s(sp[c][0], sp[c][1]); w.y = cvtpk_s(sp[c][2], sp[c][3]); *(LAS u32x2*)(kt + row * AT_ROWB + 256 + col4 * 8) = w; }
        { const int in_ = i + 1 < 16 ? i + 1 : 15; DM_LOAD(wave + 8 * in_) }
        f32x16 s;
#pragma unroll
        for (int r = 0; r < 16; ++r) s[r] = 0.f;
#pragma unroll
        for (int ks = 0; ks < 12; ++ks) { const bf16x8 kf = *(const LAS bf16x8*)(kt + r32 * AT_ROWB + 32 * ks + 16 * hi); const bf16x8 qfr = *(const LAS bf16x8*)(ldsl + r32 * AT_ROWB + 32 * ks + 16 * hi);
            s = __builtin_amdgcn_mfma_f32_32x32x16_bf16(kf, qfr, s, 0, 0, 0); }
        float mx = s[0];
#pragma unroll
        for (int r = 1; r < 16; ++r) mx = fmaxf(mx, s[r]);
        mx = fmaxf(mx, __shfl_xor(mx, 32));
        const float mn = fmaxf(mrun, mx), alpha = __builtin_amdgcn_exp2f(mrun - mn);
        float ps = 0.f;
#pragma unroll
        for (int r = 0; r < 16; ++r) { s[r] = __builtin_amdgcn_exp2f(s[r] - mn); ps += s[r]; }
        lrun = lrun * alpha + ps; mrun = mn;
        if (__any(alpha != 1.0f)) {
#pragma unroll
            for (int d = 0; d < 4; ++d)
#pragma unroll
                for (int r = 0; r < 16; ++r) o[d][r] *= alpha; }
        bf16x8 pf[2];
#pragma unroll
        for (int s2 = 0; s2 < 2; ++s2) { u32x4 w; w.x = cvtpk_s(s[8 * s2 + 0], s[8 * s2 + 1]); w.y = cvtpk_s(s[8 * s2 + 2], s[8 * s2 + 3]); w.z = cvtpk_s(s[8 * s2 + 4], s[8 * s2 + 5]); w.w = cvtpk_s(s[8 * s2 + 6], s[8 * s2 + 7]); pf[s2] = __builtin_bit_cast(bf16x8, w); }
#pragma unroll
        for (int d = 0; d < 4; ++d)
#pragma unroll
            for (int s2 = 0; s2 < 2; ++s2) { const int R = 16 * s2 + 4 * hi; const LAS unsigned char* vp = kt + (R + q4) * AT_ROWB + (32 * d + 16 * blk) * 2 + 8 * p4;
                const s16x4 lo = vtr(vp), hi4 = vtr(vp + 8 * AT_ROWB); const bf16x8 vf = (bf16x8){lo[0], lo[1], lo[2], lo[3], hi4[0], hi4[1], hi4[2], hi4[3]};
                o[d] = __builtin_amdgcn_mfma_f32_32x32x16_bf16(vf, pf[s2], o[d], 0, 0, 0); }
    }
#undef DM_LOAD
    const float ltot = lrun + __shfl_xor(lrun, 32);
    asm volatile("s_waitcnt vmcnt(0) lgkmcnt(0)" ::: "memory");
    LAS float* sw = (LAS float*)kt;
    if (r32 < 4) {
#pragma unroll
        for (int d = 0; d < 4; ++d)
#pragma unroll
            for (int r = 0; r < 16; ++r) sw[r32 * 130 + 32 * d + crow(r, hi)] = o[d][r];
        if (hi == 0) { sw[r32 * 130 + 128] = mrun; sw[r32 * 130 + 129] = ltot; } }
    __syncthreads();
    {   const int h = tid >> 7, dim = tid & 127; float M = -1e30f;
#pragma unroll
        for (int w = 0; w < 8; ++w) M = fmaxf(M, ((const LAS float*)(ldsl + (1 + w) * DQ_BYTES))[h * 130 + 128]);
        float L = 0.f, O = 0.f;
#pragma unroll
        for (int w = 0; w < 8; ++w) { const LAS float* pw = (const LAS float*)(ldsl + (1 + w) * DQ_BYTES) + h * 130; const float f = __builtin_amdgcn_exp2f(pw[128] - M); L += pw[129] * f; O += pw[dim] * f; }
        float* pp = PART + (size_t)(item * 4 + h) * 132; pp[dim] = O; if (dim == 0) { pp[128] = M; pp[129] = L; } }
    __syncthreads();
}

template <int NB>
__device__ __forceinline__ void skinny_tile(LAS unsigned char* ldsl, const bf16_t* A, int lda, const bf16_t* B0, const bf16_t* B1, int K, int lane, int wave, f32x4 (&acc)[NB], float& ssq) {
    const int r16 = lane & 15, kq = lane >> 4; int kw = K >> 3; asm volatile("" : "+s"(kw));
    f32x4 pa[NB][8]; float ps[8];
#pragma unroll
    for (int g = 0; g < 8; ++g) { ps[g] = 0.f;
#pragma unroll
        for (int n = 0; n < NB; ++n) pa[n][g] = (f32x4){0.f, 0.f, 0.f, 0.f}; }
    const bf16_t* ap = A + (size_t)r16 * lda + wave * kw + 8 * kq;
    const bf16_t* bp0 = B0 + (size_t)r16 * K + wave * kw + 8 * kq; const bf16_t* bp1 = B1 + (size_t)r16 * K + wave * kw + 8 * kq;
    if (NB == 1) {
#pragma unroll 4
    for (int k0 = 0; k0 < kw; k0 += 32) {
        const bf16x8 b0 = *(const bf16x8*)(bp0 + k0); bf16x8 b1 = b0; if (NB == 2) b1 = *(const bf16x8*)(bp1 + k0);
#pragma unroll
        for (int g = 0; g < 8; ++g) { const u32x4 a = *(const u32x4*)(ap + (size_t)(16 * g) * lda + k0);
            pa[0][g] = __builtin_amdgcn_mfma_f32_16x16x32_bf16(__builtin_bit_cast(bf16x8, a), b0, pa[0][g], 0, 0, 0);
            if (NB == 2) pa[NB - 1][g] = __builtin_amdgcn_mfma_f32_16x16x32_bf16(__builtin_bit_cast(bf16x8, a), b1, pa[NB - 1][g], 0, 0, 0);
            const float a0 = __uint_as_float(a.x << 16), a1 = __uint_as_float(a.x & 0xffff0000u), a2 = __uint_as_float(a.y << 16), a3 = __uint_as_float(a.y & 0xffff0000u);
            const float a4 = __uint_as_float(a.z << 16), a5 = __uint_as_float(a.z & 0xffff0000u), a6 = __uint_as_float(a.w << 16), a7 = __uint_as_float(a.w & 0xffff0000u);
            ps[g] += (a0 * a0 + a1 * a1) + (a2 * a2 + a3 * a3) + (a4 * a4 + a5 * a5) + (a6 * a6 + a7 * a7); }
    }
    } else {
#pragma unroll 2
    for (int k0 = 0; k0 < kw; k0 += 32) {
        const bf16x8 b0 = *(const bf16x8*)(bp0 + k0); bf16x8 b1 = b0; if (NB == 2) b1 = *(const bf16x8*)(bp1 + k0);
#pragma unroll
        for (int g = 0; g < 8; ++g) { const u32x4 a = *(const u32x4*)(ap + (size_t)(16 * g) * lda + k0);
            pa[0][g] = __builtin_amdgcn_mfma_f32_16x16x32_bf16(__builtin_bit_cast(bf16x8, a), b0, pa[0][g], 0, 0, 0);
            if (NB == 2) pa[NB - 1][g] = __builtin_amdgcn_mfma_f32_16x16x32_bf16(__builtin_bit_cast(bf16x8, a), b1, pa[NB - 1][g], 0, 0, 0);
            const float a0 = __uint_as_float(a.x << 16), a1 = __uint_as_float(a.x & 0xffff0000u), a2 = __uint_as_float(a.y << 16), a3 = __uint_as_float(a.y & 0xffff0000u);
            const float a4 = __uint_as_float(a.z << 16), a5 = __uint_as_float(a.z & 0xffff0000u), a6 = __uint_as_float(a.w << 16), a7 = __uint_as_float(a.w & 0xffff0000u);
            ps[g] += (a0 * a0 + a1 * a1) + (a2 * a2 + a3 * a3) + (a4 * a4 + a5 * a5) + (a6 * a6 + a7 * a7); }
    }
    }
    LAS f32x4* red = (LAS f32x4*)ldsl; LAS float* rs = (LAS float*)(ldsl + 131072 + 1024);
#pragma unroll
    for (int g = 0; g < 8; ++g) {
#pragma unroll
        for (int n = 0; n < NB; ++n) red[((wave * NB + n) * 8 + g) * 64 + lane] = pa[n][g];
        float s = ps[g]; s += __shfl_xor(s, 16); s += __shfl_xor(s, 32); if (kq == 0) rs[(wave * 8 + g) * 16 + r16] = s; }
    __syncthreads();
#pragma unroll
    for (int n = 0; n < NB; ++n) { f32x4 s = red[((0 * NB + n) * 8 + wave) * 64 + lane];
#pragma unroll
        for (int w = 1; w < 8; ++w) s += red[((w * NB + n) * 8 + wave) * 64 + lane];
        acc[n] = s; }
    { float s = 0.f;
#pragma unroll
      for (int w = 0; w < 8; ++w) s += rs[(w * 8 + wave) * 16 + r16];
      ssq = s; }
    __syncthreads();
}
__device__ __forceinline__ bf16_t f2bf1(float v) { return (bf16_t)(pg8::cvt_pk_bf16(v, 0.f) & 0xffffu); }
template <bool HAS_RS> __device__ __forceinline__ void sk_swiglu(LAS unsigned char* ldsl, const bf16_t* XBs, const bf16_t* WGU, bf16_t* Hs, int lane, int wave) {
    for (int t = blockIdx.x; t < DFF / 16; t += gridDim.x) {
        const int n0 = 256 * (t >> 3) + 16 * (t & 7); f32x4 acc[2]; float ssq;
        skinny_tile<2>(ldsl, XBs, DM, WGU + (size_t)n0 * DM, WGU + (size_t)(n0 + 128) * DM, DM, lane, wave, acc, ssq);
#pragma unroll
        for (int i = 0; i < 4; ++i) { const int rl = 4 * (lane >> 4) + i; const float rs = HAS_RS ? 1.0f / sqrtf(__shfl(ssq, rl) * (1.f / 1024.f) + EPS) : 1.0f;
            Hs[(size_t)(16 * wave + rl) * DFF + 16 * t + (lane & 15)] = f2bf1(silu_fast(acc[0][i] * rs) * (acc[1][i] * rs)); }
    }
}
__device__ __forceinline__ void sk_resid(LAS unsigned char* ldsl, const bf16_t* As, int K, const bf16_t* Wt, const float* bases, float* Xs, bf16_t* XBs, float scale, int lane, int wave) {
    for (int t = blockIdx.x; t < DM / 16; t += gridDim.x) {
        f32x4 acc[1]; float ssq;
        skinny_tile<1>(ldsl, As, K, Wt + (size_t)(16 * t) * K, Wt, K, lane, wave, acc, ssq);
#pragma unroll
        for (int i = 0; i < 4; ++i) { const size_t o = (size_t)(16 * wave + 4 * (lane >> 4) + i) * DM + 16 * t + (lane & 15); const float v = bases[o] + scale * acc[0][i]; Xs[o] = v; XBs[o] = f2bf1(v); }
    }
}
__device__ __forceinline__ void sk_proj(LAS unsigned char* ldsl, const bf16_t* X1Bs, const bf16_t* WINt, bf16_t* QGs, bf16_t* KGs, float* VSs, bf16_t* SGs, bf16_t* CQBs, float* CKVs, float* KPRs, float* ALOWs, int lane, int wave) {
    for (int t = blockIdx.x; t < 125; t += gridDim.x) {
        f32x4 acc[1]; float ssq;
        skinny_tile<1>(ldsl, X1Bs, DM, WINt + (size_t)(16 * t) * DM, WINt, DM, lane, wave, acc, ssq);
        const int c = 16 * t + (lane & 15);
#pragma unroll
        for (int i = 0; i < 4; ++i) { const int rl = 4 * (lane >> 4) + i; const size_t r = (size_t)(16 * wave + rl); const float v = acc[0][i] / sqrtf(__shfl(ssq, rl) * (1.f / 1024.f) + EPS);
            if (t < 16) QGs[r * 256 + c] = f2bf1(v * 0.125f);
            else if (t < 32) KGs[r * 256 + (c - 256)] = f2bf1(v);
            else if (t < 64) VSs[r * 512 + (c - 512)] = v;
            else if (t < 96) SGs[r * 512 + (c - 1024)] = f2bf1(silu_fast(v));
            else if (t < 112) CQBs[r * 256 + (c - 1536)] = f2bf1(v);
            else if (t < 120) CKVs[r * 128 + (c - 1792)] = v;
            else if (t < 124) KPRs[r * 64 + (c - 1920)] = v;
            else ALOWs[r * 16 + (c - 1984)] = v; }
    }
}
__device__ __forceinline__ void sk_qabs(LAS unsigned char* ldsl, const bf16_t* CQBs, const bf16_t* WQAt, bf16_t* QAs, int lane, int wave) {
    for (int t = (int)((blockIdx.x + gridDim.x / 2u) % gridDim.x); t < 48; t += gridDim.x) {
        f32x4 acc[1]; float ssq;
        skinny_tile<1>(ldsl, CQBs, 256, WQAt + (size_t)(16 * t) * 256, WQAt, 256, lane, wave, acc, ssq);
#pragma unroll
        for (int i = 0; i < 4; ++i) { const int rl = 4 * (lane >> 4) + i; const float rq = QSCALE / sqrtf(__shfl(ssq, rl) * (1.f / 256.f) + EPS);
            QAs[(size_t)(16 * wave + rl) * 768 + 16 * t + (lane & 15)] = f2bf1(acc[0][i] * rq); }
    }
}

struct MapId { __device__ __forceinline__ int operator()(int n) const { return n; } };
struct MapGU { int off; __device__ __forceinline__ int operator()(int n) const { return 256 * (n >> 7) + (n & 127) + off; } };
struct MapWin { __device__ __forceinline__ int operator()(int n) const { return n < 1536 ? n : (n < 1552 ? n + 448 : n - 16); } };
template <class Map>
__device__ __forceinline__ void tr_item(const float* W, int K, int N, const float* kscale, bf16_t* WT, const Map map, LAS float* scr, int item, int lane, int ldk = 0) {
    if (ldk == 0) ldk = K;
    const int nblk = (N + 63) / 64, kb = item / nblk, nb = item - kb * nblk, k0 = 64 * kb, n0 = 64 * nb;
    const int c4 = lane & 15, kr = lane >> 4, nn = n0 + 4 * c4;
    f32x4 v[16];
#pragma unroll
    for (int i = 0; i < 16; ++i) { v[i] = (f32x4){0.f, 0.f, 0.f, 0.f}; if (nn < N) v[i] = *(const f32x4*)(W + (size_t)(k0 + kr + 4 * i) * N + nn); }
#pragma unroll
    for (int i = 0; i < 16; ++i) { const int kk = kr + 4 * i; const float s = kscale ? kscale[k0 + kk] : 1.0f; LAS float* d = scr + kk * 65 + 4 * c4; d[0] = v[i][0] * s; d[1] = v[i][1] * s; d[2] = v[i][2] * s; d[3] = v[i][3] * s; }
    asm volatile("s_waitcnt lgkmcnt(0)" ::: "memory");
    const int c = lane & 7;
#pragma unroll
    for (int j = 0; j < 8; ++j) { const int n = (lane >> 3) + 8 * j; const LAS float* s = scr + (8 * c) * 65 + n;
        u32x4 o; o.x = pg8::cvt_pk_bf16(s[0 * 65], s[1 * 65]); o.y = pg8::cvt_pk_bf16(s[2 * 65], s[3 * 65]); o.z = pg8::cvt_pk_bf16(s[4 * 65], s[5 * 65]); o.w = pg8::cvt_pk_bf16(s[6 * 65], s[7 * 65]);
        if (n0 + n < N) *(u32x4*)(WT + (size_t)map(n0 + n) * ldk + k0 + 8 * c) = o; }
    asm volatile("s_waitcnt lgkmcnt(0)" ::: "memory");
}

struct EpiVT { static constexpr bool PERM = true, AFTER_DRAIN = false;
    bf16_t* VT; const LAS float* tab;
    __device__ __forceinline__ void operator()(const f32x4 (&acc)[2][2][4][2], const pg8::Unit& u, int wr, int wc, int fr, int fq) const {
        const int tok0 = u.pn * 256 + wc * 32 + 8 * fq, bb = tok0 >> 11, t0 = tok0 & 2047;
        f32x4 rs[2][2];
#pragma unroll
        for (int bj = 0; bj < 2; ++bj)
#pragma unroll
            for (int n = 0; n < 2; ++n) rs[bj][n] = *(const LAS f32x4*)(tab + bj * 128 + wc * 32 + 8 * fq + 4 * n);
#pragma unroll
        for (int ai = 0; ai < 2; ++ai)
#pragma unroll
            for (int m = 0; m < 4; ++m) { const int cv = u.pm * 256 + ai * 128 + wr * 64 + m * 16 + fr;
                bf16_t* p = VT + ((size_t)((bb * 4 + (cv >> 7)) * 128 + (cv & 127))) * 2048 + t0;
#pragma unroll
                for (int bj = 0; bj < 2; ++bj) { const f32x4 o0 = acc[ai][bj][m][0] * rs[bj][0], o1 = acc[ai][bj][m][1] * rs[bj][1];
                    u32x4 w; w.x = pg8::cvt_pk_bf16(o0[0], o0[1]); w.y = pg8::cvt_pk_bf16(o0[2], o0[3]); w.z = pg8::cvt_pk_bf16(o1[0], o1[1]); w.w = pg8::cvt_pk_bf16(o1[2], o1[3]);
                    *(u32x4*)(p + bj * 128) = w; } }
    }
};
struct OneUnit { pg8::Unit u0;
    __device__ __forceinline__ bool next(int i, pg8::Unit& u) const { if (i != 0) return false; u = u0; return true; }
    __device__ __forceinline__ void a_ready(const pg8::Unit&) const {}
    __device__ __forceinline__ void done(const pg8::Unit&) const {}
};
struct SkipVOrder { pg8::StaticOrder S;
    __host__ __device__ void init(int M, int N, int G_, int c_) { S.init(M, N, G_, c_); }
    __host__ __device__ bool next(int i, pg8::Unit& u) const { if (!S.next(i, u)) return false; u.pn += u.pn >= 2 ? 2 : 0; return true; }
    __device__ __forceinline__ void a_ready(const pg8::Unit&) const {}
    __device__ __forceinline__ void done(const pg8::Unit&) const {}
};
template <class Sched> __device__ __forceinline__ RsTab build_rstab(LAS unsigned char* ldsl_, const Sched& S, const float* slots, int tid_) {
    RsTab T; T.p0 = T.p1 = T.p2 = T.p3 = -1; T.tab = (const LAS float*)(ldsl_ + RSTAB_OFF); int n = 0; pg8::Unit u;
    for (int i = 0; S.next(i, u); ++i) { if (u.pm != T.p0 && u.pm != T.p1 && u.pm != T.p2 && u.pm != T.p3) { if (n == 0) T.p0 = u.pm; else if (n == 1) T.p1 = u.pm; else if (n == 2) T.p2 = u.pm; else if (n == 3) T.p3 = u.pm; ++n; } }
    LAS float* tab = (LAS float*)(ldsl_ + RSTAB_OFF);
    const int rit = tid_ & 255, s0 = tid_ >> 8;
#pragma unroll
    for (int k = 0; k < 2; ++k) { const int s = s0 + 2 * k; const int pm = s == 0 ? T.p0 : (s == 1 ? T.p1 : (s == 2 ? T.p2 : T.p3)); if (pm >= 0) tab[s * 256 + rit] = rstd_from(slots, 16, pm * 256 + rit); }
    __syncthreads();
    return T;
}

struct Args { const void* in[26]; float* out; unsigned char* ws; int ph_lo, ph_hi, one, pad; };
constexpr int NPHASE = 11;

__global__ void __launch_bounds__(NTHR, 2) fwd_kernel(Args args) {
    extern __shared__ __attribute__((aligned(16))) unsigned char lds_raw[];
#define lds ((float*)lds_raw)
#define ldsl ((LAS unsigned char*)lds_raw)
#define MISC ((volatile LAS unsigned*)(ldsl + MISC_OFF))
#define tid ((int)threadIdx.x)
#define lane ((int)(threadIdx.x & 63u))
#define wave ((int)__builtin_amdgcn_readfirstlane((int)(threadIdx.x >> 6)))
#define gtid ((int)(blockIdx.x * NTHR + threadIdx.x))
#define gthr ((int)(gridDim.x * NTHR))
#define gw ((int)(blockIdx.x * (NTHR / 64)) + wave)
#define ngw ((int)(gridDim.x * (NTHR / 64)))
    if (tid < 32) MISC[tid] = 0u;
    __syncthreads();
    XcdBarrier bar; bar.bar = (unsigned*)args.ws + 4096; bar.x = 0; bar.st = nullptr;
    if (args.one) bar = xcd_barrier_post((unsigned*)args.ws + 4096, MISC + 8);

    float* out = args.out;
    unsigned char* ws = args.ws;
#define x_p ((const float*)((const float*)args.in[0]))
#define x_s ((const float*)((const float*)args.in[1]))
#define cache_kv ((const float*)((const float*)args.in[2]))
#define cache_pe ((const float*)((const float*)args.in[3]))
#define state_gla ((const float*)((const float*)args.in[4]))
#define page_table ((const int*)((const int*)args.in[5]))
#define f1n ((const float*)((const float*)args.in[6]))
#define f1g ((const float*)((const float*)args.in[7]))
#define f1u ((const float*)((const float*)args.in[8]))
#define f1d ((const float*)((const float*)args.in[9]))
#define mixn ((const float*)((const float*)args.in[10]))
#define w_in ((const float*)((const float*)args.in[11]))
#define w_a_up ((const float*)((const float*)args.in[12]))
#define b_a ((const float*)((const float*)args.in[13]))
#define gnw ((const float*)((const float*)args.in[14]))
#define qnw ((const float*)((const float*)args.in[15]))
#define w_uq ((const float*)((const float*)args.in[16]))
#define kvnw ((const float*)((const float*)args.in[17]))
#define w_uk ((const float*)((const float*)args.in[18]))
#define w_uv ((const float*)((const float*)args.in[19]))
#define w_out ((const float*)((const float*)args.in[20]))
#define f2n ((const float*)((const float*)args.in[21]))
#define f2g ((const float*)((const float*)args.in[22]))
#define f2u ((const float*)((const float*)args.in[23]))
#define f2d ((const float*)((const float*)args.in[24]))
#define fnw ((const float*)((const float*)args.in[25]))
#define WGU1 ((bf16_t*)((bf16_t*)(ws + B_WGU1)))
#define WD1 ((bf16_t*)((bf16_t*)(ws + B_WD1)))
#define WIN ((bf16_t*)((bf16_t*)(ws + B_WIN)))
#define WOUT ((bf16_t*)((bf16_t*)(ws + B_WOUT)))
#define WGU2 ((bf16_t*)((bf16_t*)(ws + B_WGU2)))
#define WD2 ((bf16_t*)((bf16_t*)(ws + B_WD2)))
#define XB ((bf16_t*)((bf16_t*)(ws + B_XB)))
#define SSQ0 ((float*)((float*)(ws + B_SSQ0)))
#define H ((bf16_t*)((bf16_t*)(ws + B_H)))
#define X1 ((float*)((float*)(ws + B_X1)))
#define X1B ((bf16_t*)((bf16_t*)(ws + B_X1B)))
#define SSQ1 ((float*)((float*)(ws + B_SSQ1)))
#define X2 ((float*)((float*)(ws + B_X2)))
#define X2B ((bf16_t*)((bf16_t*)(ws + B_X2B)))
#define SSQ2 ((float*)((float*)(ws + B_SSQ2)))
#define X3 ((float*)((float*)(ws + B_X3)))
#define X3B ((bf16_t*)((bf16_t*)(ws + B_X3B)))
#define SSQ3 ((float*)((float*)(ws + B_SSQ3)))
#define YMIXB ((bf16_t*)((bf16_t*)(ws + B_YMIXB)))
#define PROJ ((float*)((float*)(ws + B_PROJ)))
#define OG ((float*)((float*)(ws + B_OG)))
#define QF ((float*)((float*)(ws + B_QF)))
#define LAT ((float*)((float*)(ws + B_LAT)))
#define KPE ((float*)((float*)(ws + B_KPE)))
#define KN ((float*)((float*)(ws + B_KN)))
#define VV ((float*)((float*)(ws + B_VV)))
#define CQN ((float*)((float*)(ws + B_CQN)))
#define QLAT ((float*)((float*)(ws + B_QLAT)))
#define OLAT ((float*)((float*)(ws + B_OLAT)))
#define WQA ((bf16_t*)((bf16_t*)(ws + B_WQA)))
#define RT ((float2*)((float2*)(ws + B_RT)))
#define CQB ((bf16_t*)((bf16_t*)(ws + B_CQB)))
#define CQS ((float*)((float*)(ws + B_CQS)))
#define CKV ((float*)((float*)(ws + B_CKV)))
#define KPR ((float*)((float*)(ws + B_KPR)))
#define KL ((bf16_t*)((bf16_t*)(ws + B_KL)))
#define QA ((bf16_t*)((bf16_t*)(ws + B_QA)))
#define QG ((bf16_t*)((bf16_t*)(ws + B_QG)))
#define KG ((bf16_t*)((bf16_t*)(ws + B_KG)))
#define VT ((bf16_t*)((bf16_t*)(ws + B_VT)))
#define VS ((float*)((float*)(ws + B_VS)))
#define SG ((bf16_t*)((bf16_t*)(ws + B_SG)))
#define ALOW ((float*)((float*)(ws + B_ALOW)))
#define DEC ((float*)((float*)(ws + B_DEC)))
#define UT ((bf16_t*)(ws + B_UT))
#define ST ((bf16_t*)((bf16_t*)(ws + B_ST)))
#define PART ((float*)(ws + B_PART))
    const Rows2 Xin{x_p, x_s, MP, DM};

    const int lo = args.ph_lo, hi = args.ph_hi;
#define IN(k) (lo <= (k) && (k) < hi)
#define SEAM(k) do { if (IN(k) && IN((k) + 1)) xcd_barrier(bar); } while (0)

    if (IN(0)) {
        LAS float* scr = (LAS float*)ldsl + wave * 4160;
        constexpr int I_G = 16 * 44, I_D = 44 * 16, I_IN = 16 * 32, I_OUT = 8 * 16;
        constexpr int NIT = 6 * I_G + I_IN + I_OUT;
        static_assert(I_G == I_D, "items");
        for (int it = gw; it < NIT; it += ngw) {
            int r = it;
            if (r < I_G) { tr_item(f1g, DM, DFF, f1n, WGU1, MapGU{0}, scr, r, lane); continue; } r -= I_G;
            if (r < I_G) { tr_item(f1u, DM, DFF, f1n, WGU1, MapGU{128}, scr, r, lane); continue; } r -= I_G;
            if (r < I_D) { tr_item(f1d, DFF, DM, nullptr, WD1, MapId{}, scr, r, lane); continue; } r -= I_D;
            if (r < I_G) { tr_item(f2g, DM, DFF, f2n, WGU2, MapGU{0}, scr, r, lane); continue; } r -= I_G;
            if (r < I_G) { tr_item(f2u, DM, DFF, f2n, WGU2, MapGU{128}, scr, r, lane); continue; } r -= I_G;
            if (r < I_D) { tr_item(f2d, DFF, DM, nullptr, WD2, MapId{}, scr, r, lane); continue; } r -= I_D;
            if (r < I_IN) { tr_item(w_in, DM, INW, mixn, WIN, MapWin{}, scr, r, lane); continue; } r -= I_IN;
            tr_item(w_out, 512, DM, nullptr, WOUT, MapId{}, scr, r, lane, DM);
        }
        for (int it = gw; it < 2048; it += ngw) { const int ng = it & 15, cg = (it >> 4) & 31, h = it >> 9, n = ng * 64 + lane;
            const float* wv = w_uv + (size_t)(cg * 4) * 512 + h * 128; const float* wo = w_out + (size_t)(512 + h * 128) * DM + n; float s0 = 0.f, s1 = 0.f, s2 = 0.f, s3 = 0.f;
#pragma unroll 32
            for (int d = 0; d < 128; ++d) { const float o = wo[(size_t)d * DM]; s0 += wv[d] * o; s1 += wv[512 + d] * o; s2 += wv[1024 + d] * o; s3 += wv[1536 + d] * o; }
            u32x2 w; w.x = pg8::cvt_pk_bf16(s0, s1); w.y = pg8::cvt_pk_bf16(s2, s3); *(u32x2*)(WOUT + (size_t)n * DM + 512 + h * 128 + cg * 4) = w; }
        for (int it = gw; it < 512; it += ngw) { const int kg4 = it & 3, cg = (it >> 2) & 31, h = it >> 7, k = kg4 * 64 + lane;
            const f32x4* wq = (const f32x4*)(w_uq + (size_t)k * 768 + h * 192); const float* wk = w_uk + (size_t)(cg * 4) * 512 + h * 128; float s0 = 0.f, s1 = 0.f, s2 = 0.f, s3 = 0.f;
#pragma unroll 16
            for (int d4 = 0; d4 < 32; ++d4) { const f32x4 q = wq[d4];
#pragma unroll
                for (int e = 0; e < 4; ++e) { const int d = 4 * d4 + e; s0 += q[e] * wk[d]; s1 += q[e] * wk[512 + d]; s2 += q[e] * wk[1024 + d]; s3 += q[e] * wk[1536 + d]; } }
            const float g = qnw[k]; bf16_t* dst = WQA + (size_t)(h * 128 + cg * 4) * 256 + k;
            const unsigned lo = pg8::cvt_pk_bf16(s0 * g, s1 * g), hi = pg8::cvt_pk_bf16(s2 * g, s3 * g);
            dst[0] = (bf16_t)(lo & 0xffffu); dst[256] = (bf16_t)(lo >> 16); dst[512] = (bf16_t)(hi & 0xffffu); dst[768] = (bf16_t)(hi >> 16); }
        for (int e = gtid; e < 256 * 256; e += gthr) { const int k = e & 255, rr = e >> 8, h = rr >> 6, j = rr & 63, i = j >> 1, ee = j & 1;
            WQA[(size_t)(512 + rr) * 256 + k] = (bf16_t)(pg8::cvt_pk_bf16(w_uq[(size_t)k * 768 + h * 192 + 128 + 32 * ee + i] * qnw[k], 0.f) & 0xffffu); }
        for (int e = gtid; e < 2049 * 32; e += gthr) { const int i = e & 31, p = e >> 5; float c, s; rope_cs(p < SEQ ? p : PAST, i, c, s); RT[e] = make_float2(c, s); }
        for (int e = gtid; e < 48 * 1024 / 8; e += gthr) ((u32x4*)(WIN + (size_t)2000 * 1024))[e] = (u32x4){0u, 0u, 0u, 0u};
        for (int r4 = ngw - 1 - gw; r4 < MT / 4; r4 += ngw) {
            float4 v[4][4]; float s[4];
#pragma unroll
            for (int q = 0; q < 4; ++q) { const float4* p = (const float4*)Xin.row(4 * r4 + q) + lane;
#pragma unroll
                for (int j = 0; j < 4; ++j) v[q][j] = p[64 * j]; }
#pragma unroll
            for (int q = 0; q < 4; ++q) { s[q] = 0.f;
#pragma unroll
                for (int j = 0; j < 4; ++j) s[q] += (v[q][j].x * v[q][j].x + v[q][j].y * v[q][j].y) + (v[q][j].z * v[q][j].z + v[q][j].w * v[q][j].w); }
#pragma unroll
            for (int o = 1; o < 64; o <<= 1) {
#pragma unroll
                for (int q = 0; q < 4; ++q) s[q] += __shfl_xor(s[q], o); }
#pragma unroll
            for (int q = 0; q < 4; ++q) { const float rs = 1.0f / sqrtf(s[q] * (1.f / 1024.f) + EPS);
#pragma unroll
                for (int j = 0; j < 4; ++j) { u32x2 w; w.x = pg8::cvt_pk_bf16(v[q][j].x * rs, v[q][j].y * rs); w.y = pg8::cvt_pk_bf16(v[q][j].z * rs, v[q][j].w * rs); ((u32x2*)(XB + (size_t)(4 * r4 + q) * DM))[lane + 64 * j] = w; } }
        }
    } SEAM(0);
    if (IN(1)) {
        sk_swiglu<false>(ldsl, XB + (size_t)MP * DM, WGU1, H + (size_t)MP * DFF, lane, wave);
        pg8::Gemm g{XB, WGU1, MP, 2 * DFF, DM}; pg8::StaticOrder S; S.init(MP, 2 * DFF, gridDim.x, (int)blockIdx.x);
        EpiSwigluB<false> E{H, SSQ0, 1, RsTab{-1, -1, -1, -1, nullptr}}; pg8::gemm_phase<EpiSwigluB<false>, pg8::StaticOrder, PG8_ALIGN, PG8_SP2>(ldsl, g, S, E); } SEAM(1);
    if (IN(2)) {
        sk_resid(ldsl, H + (size_t)MP * DFF, DFF, WD1, x_s, X1 + (size_t)MP * DM, X1B + (size_t)MP * DM, 0.5f, lane, wave);
        pg8::Gemm g{H, WD1, MP, DM, DFF}; pg8::StaticOrder S; S.init(MP, DM, gridDim.x, (int)blockIdx.x);
        EpiResidB<false> E{x_p, nullptr, X1B, SSQ1, 0.5f}; pg8::gemm_phase<EpiResidB<false>, pg8::StaticOrder, PG8_ALIGN, PG8_SP2>(ldsl, g, S, E); } SEAM(2);
    if (IN(3)) {
        sk_proj(ldsl, X1B + (size_t)MP * DM, WIN, QG + (size_t)MP * 256, KG + (size_t)MP * 256, VS, SG + (size_t)MP * 512, CQB + (size_t)MP * 256, CKV + (size_t)MP * 128, KPR + (size_t)MP * 64, ALOW + (size_t)MP * 16, lane, wave);
        { pg8::Gemm g{X1B, WIN, MP, 2048, DM}; SkipVOrder S; S.init(MP, 1536, gridDim.x, (int)blockIdx.x);
          const RsTab RT3 = build_rstab(ldsl, S, SSQ1, tid); EpiProj2 E{PROJ, SSQ1, RT3, CQB, CQS, CKV, KPR, QG, KG, VT, VS, SG, ALOW}; pg8::gemm_phase<EpiProj2, SkipVOrder, PG8_ALIGN, PG8_SP2>(ldsl, g, S, E); }
        { pg8::Gemm gv{WIN + (size_t)C_V * DM, X1B, 512, MP, DM};
          pg8::Unit uv; LAS float* tab = (LAS float*)(ldsl + RSTAB_OFF);
#pragma unroll 1
          for (int L = (int)blockIdx.x; L < 256; L += (int)gridDim.x) { const int wg = (L & 7) * 32 + (L >> 3); uv.pm = wg & 1; uv.pn = wg >> 1;
              __syncthreads();
              if (tid < 256) tab[tid] = rstd_from(SSQ1, 16, uv.pn * 256 + tid);
              __syncthreads();
              OneUnit O1{uv}; EpiVT EV{VT, (const LAS float*)tab}; pg8::gemm_phase<EpiVT, OneUnit, PG8_ALIGN, PG8_SP2>(ldsl, gv, O1, EV); } } } SEAM(3);
    if (IN(4)) {
        for (int r4 = ngw - 1 - gw; r4 < MT / 4; r4 += ngw) {
            float2 cv[4]; float x1[4], x2[4]; float2 cs[4]; float ss[4];
#pragma unroll
            for (int q = 0; q < 4; ++q) { const int r = 4 * r4 + q; const int pidx = r < MP ? (r & (SEQ - 1)) : SEQ;
                cv[q] = *(const float2*)(CKV + (size_t)r * 128 + lane * 2);
                x1[q] = KPR[(size_t)r * 64 + (lane & 31)]; x2[q] = KPR[(size_t)r * 64 + 32 + (lane & 31)]; cs[q] = RT[(size_t)pidx * 32 + (lane & 31)]; }
#pragma unroll
            for (int q = 0; q < 4; ++q) ss[q] = cv[q].x * cv[q].x + cv[q].y * cv[q].y;
#pragma unroll
            for (int o = 1; o < 64; o <<= 1) {
#pragma unroll
                for (int q = 0; q < 4; ++q) ss[q] += __shfl_xor(ss[q], o); }
            const float2 w = *(const float2*)(kvnw + lane * 2);
#pragma unroll
            for (int q = 0; q < 4; ++q) { const int r = 4 * r4 + q;
                const float rstd = 1.0f / sqrtf(ss[q] * (1.f / 128.f) + EPS);
                const float2 y = make_float2(cv[q].x * rstd * w.x, cv[q].y * rstd * w.y);
                float* o = r < MP ? out + O_KVP + (size_t)r * 128 : out + O_KVS + (size_t)(r - MP) * 128;
                *(float2*)(o + lane * 2) = y;
                *(unsigned*)(KL + (size_t)r * 192 + lane * 2) = pg8::cvt_pk_bf16(y.x, y.y);
                if (lane < 32) {
                    const float y1 = x1[q] * cs[q].x - x2[q] * cs[q].y, y2 = x1[q] * cs[q].y + x2[q] * cs[q].x;
                    float* op = r < MP ? out + O_PEP + (size_t)r * 64 : out + O_PES + (size_t)(r - MP) * 64;
                    op[lane] = y1; op[32 + lane] = y2;
                    *(unsigned*)(KL + (size_t)r * 192 + 128 + 2 * lane) = pg8::cvt_pk_bf16(y1, y2); } }
        }
        for (int u = gw; u < 2048; u += ngw) gla_prep_unit(ldsl + wave * KTT_BYTES, QG, KG, ALOW, w_a_up, b_a, VT, DEC, UT, u, lane);
        __syncthreads();
        { pg8::Gemm g{CQB, WQA, MP, 768, 256}; pg8::StaticOrder S; S.init(MP, 768, gridDim.x, (int)blockIdx.x);
          EpiQabs E{QA, CQS, RT}; pg8::gemm_phase<EpiQabs, pg8::StaticOrder, PG8_ALIGN, PG8_SP2>(ldsl, g, S, E); }
        sk_qabs(ldsl, CQB + (size_t)MP * 256, WQA, QA + (size_t)MP * 768, lane, wave);
    } SEAM(4);
    if (IN(5)) {
        const bool memfirst = ((blockIdx.x >> 3) & 7) < 5;
        if (memfirst) {
        for (int it = blockIdx.x; it < 256; it += gridDim.x) decode_item_mfma(ldsl, QA, RT, cache_kv, cache_pe, page_table, PART, it, tid, lane, wave);
        }
        for (int p2 = 2 * blockIdx.x; p2 < 512; p2 += 2 * gridDim.x)
#pragma unroll 1
            for (int hf = 0; hf < 2; ++hf) { const int p = p2 >> 1, b = p >> 4, qq = p & 15; mla_attn_unit(ldsl, QA, KL, RT, YMIXB, b, hf ? qq : 31 - qq, tid, lane, wave); }
        __syncthreads();
        if (!memfirst) {
        for (int it = blockIdx.x; it < 256; it += gridDim.x) decode_item_mfma(ldsl, QA, RT, cache_kv, cache_pe, page_table, PART, it, tid, lane, wave);
        }
        for (int e0 = gtid; e0 < 64 * 64 * 64; e0 += gthr) { const int d = e0 & 63, vp = (e0 >> 6) & 63, bh = e0 >> 12;
            const size_t b0 = (size_t)(bh * 32) * 8192 + (size_t)(2 * vp) * 64 + d;
            bf16_t u0[32], u1[32]; float dc[32];
#pragma unroll
            for (int c = 0; c < 32; ++c) { u0[c] = UT[b0 + (size_t)c * 8192]; u1[c] = UT[b0 + (size_t)c * 8192 + 64]; dc[c] = DEC[(size_t)(bh * 32 + c) * 64 + d]; }
            float S0 = 0.f, S1 = 0.f; bf16_t s0[32], s1[32];
#pragma unroll
            for (int c = 0; c < 32; ++c) { const unsigned pk = pg8::cvt_pk_bf16(S0, S1); s0[c] = (bf16_t)(pk & 0xffffu); s1[c] = (bf16_t)(pk >> 16);
                S0 = dc[c] * (S0 + bf2f(u0[c])); S1 = dc[c] * (S1 + bf2f(u1[c])); }
#pragma unroll
            for (int c = 0; c < 32; ++c) { ST[b0 + (size_t)c * 8192] = s0[c]; ST[b0 + (size_t)c * 8192 + 64] = s1[c]; }
            out[O_GLP + ((size_t)bh * 64 + d) * 128 + 2 * vp] = S0; out[O_GLP + ((size_t)bh * 64 + d) * 128 + 2 * vp + 1] = S1;
        }
        for (int it = wave * (int)gridDim.x + (int)blockIdx.x; it < MS * 4; it += ngw) {
            const int h = it & 3, bb = it >> 2; const size_t row = (size_t)MP + bb;
            float xg = b_a[h * 64 + lane];
#pragma unroll
            for (int r = 0; r < 16; ++r) xg += ALOW[row * 16 + r] * w_a_up[r * 256 + h * 64 + lane];
            const int ad = __float_as_int(expf(logsig_f(xg) * (1.f / 16.f))), qd = __float_as_int(bf2f(QG[row * 256 + h * 64 + lane])), kd = __float_as_int(bf2f(KG[row * 256 + h * 64 + lane]));
            const float2 vv = *(const float2*)(VS + (size_t)bb * 512 + h * 128 + 2 * lane);
            const float* st = state_gla + ((size_t)(bb * 4 + h) * 64) * 128 + 2 * lane; float* dst = out + O_GLS + ((size_t)(bb * 4 + h) * 64) * 128 + 2 * lane;
            float o0 = 0.f, o1 = 0.f;
            float2 sv[64];
#pragma unroll
            for (int dd = 0; dd < 64; ++dd) sv[dd] = *(const float2*)(st + dd * 128);
#pragma unroll
            for (int dd = 0; dd < 64; ++dd) { const float a = __int_as_float(__builtin_amdgcn_readlane(ad, dd)), q = __int_as_float(__builtin_amdgcn_readlane(qd, dd)), k = __int_as_float(__builtin_amdgcn_readlane(kd, dd));
                const float S0 = a * sv[dd].x + k * vv.x, S1 = a * sv[dd].y + k * vv.y; o0 += q * S0; o1 += q * S1; *(float2*)(dst + dd * 128) = make_float2(S0, S1); }
            const float rstd = 1.0f / sqrtf(wave_sum(o0 * o0 + o1 * o1) * (1.f / 128.f) + EPS);
            const float2 gn = *(const float2*)(gnw + 2 * lane); const unsigned sg = *(const unsigned*)(SG + row * 512 + h * 128 + 2 * lane);
            *(unsigned*)(YMIXB + row * DM + h * 128 + 2 * lane) = pg8::cvt_pk_bf16(o0 * rstd * gn.x * __uint_as_float(sg << 16), o1 * rstd * gn.y * __uint_as_float(sg & 0xffff0000u));
        }
    } SEAM(5);
    if (IN(6)) {
        for (int u = gw; u < 4096; u += ngw) gla_out_unit(ldsl + wave * GD_BYTES, QG, KG, VT, ST, SG, gnw, YMIXB, u, lane);
        for (int e = gw; e < MS * 4; e += ngw) { const int h = e & 3, bs = e >> 2; const size_t qrow = (size_t)(MP + bs);
            float part;
            {   const unsigned ql = *(const unsigned*)(QA + qrow * 768 + h * 128 + 2 * lane), kl = *(const unsigned*)(KL + qrow * 192 + 2 * lane);
                part = __uint_as_float(ql << 16) * __uint_as_float(kl << 16) + __uint_as_float(ql & 0xffff0000u) * __uint_as_float(kl & 0xffff0000u); }
            if (lane < 32) { const unsigned qp = *(const unsigned*)(QA + qrow * 768 + 512 + h * 64 + 2 * lane), kp = *(const unsigned*)(KL + qrow * 192 + 128 + 2 * lane); const float2 cs = RT[(size_t)SEQ * 32 + lane];
                const float x1 = __uint_as_float(qp << 16), x2 = __uint_as_float(qp & 0xffff0000u); part += (x1 * cs.x - x2 * cs.y) * __uint_as_float(kp << 16) + (x1 * cs.y + x2 * cs.x) * __uint_as_float(kp & 0xffff0000u); }
            const float sn = wave_sum(part);
            const float* p0 = PART + (size_t)((bs * 2) * 4 + h) * 132; const float* p1 = PART + (size_t)((bs * 2 + 1) * 4 + h) * 132;
            const float M0 = p0[128], M1 = p1[128], M = fmaxf(fmaxf(M0, M1), sn), f0 = __builtin_amdgcn_exp2f(M0 - M), f1 = __builtin_amdgcn_exp2f(M1 - M), fn = __builtin_amdgcn_exp2f(sn - M);
            const float il = 1.0f / (p0[129] * f0 + p1[129] * f1 + fn);
            const unsigned vl = *(const unsigned*)(KL + qrow * 192 + 2 * lane);
            const float2 a0 = *(const float2*)(p0 + 2 * lane), a1 = *(const float2*)(p1 + 2 * lane);
            const float o0 = (a0.x * f0 + a1.x * f1 + fn * __uint_as_float(vl << 16)) * il, o1 = (a0.y * f0 + a1.y * f1 + fn * __uint_as_float(vl & 0xffff0000u)) * il;
            *(unsigned*)(YMIXB + qrow * DM + 512 + h * 128 + 2 * lane) = pg8::cvt_pk_bf16(o0, o1); }
    } SEAM(6);
    if (IN(7)) {
        sk_resid(ldsl, YMIXB + (size_t)MP * DM, DM, WOUT, X1 + (size_t)MP * DM, X2 + (size_t)MP * DM, X2B + (size_t)MP * DM, 1.0f, lane, wave);
        pg8::Gemm g{YMIXB, WOUT, MP, DM, DM}; pg8::StaticOrder S; S.init(MP, DM, gridDim.x, (int)blockIdx.x);
        EpiResidB<true> E{nullptr, X1B, X2B, SSQ2, 1.0f}; pg8::gemm_phase<EpiResidB<true>, pg8::StaticOrder, PG8_ALIGN, PG8_SP2>(ldsl, g, S, E); } SEAM(7);
    if (IN(8)) {
        sk_swiglu<true>(ldsl, X2B + (size_t)MP * DM, WGU2, H + (size_t)MP * DFF, lane, wave);
        pg8::Gemm g{X2B, WGU2, MP, 2 * DFF, DM}; pg8::StaticOrder S; S.init(MP, 2 * DFF, gridDim.x, (int)blockIdx.x);
        const RsTab RT8 = build_rstab(ldsl, S, SSQ2, tid); EpiSwigluB<true> E{H, SSQ2, 16, RT8}; pg8::gemm_phase<EpiSwigluB<true>, pg8::StaticOrder, PG8_ALIGN, PG8_SP2>(ldsl, g, S, E); } SEAM(8);
    if (IN(9)) {
        sk_resid(ldsl, H + (size_t)MP * DFF, DFF, WD2, X2 + (size_t)MP * DM, X3 + (size_t)MP * DM, X3B + (size_t)MP * DM, 0.5f, lane, wave);
        pg8::Gemm g{H, WD2, MP, DM, DFF}; pg8::StaticOrder S; S.init(MP, DM, gridDim.x, (int)blockIdx.x);
        EpiResidB<true> E{nullptr, X2B, X3B, SSQ3, 0.5f}; pg8::gemm_phase<EpiResidB<true>, pg8::StaticOrder, PG8_ALIGN, PG8_SP2>(ldsl, g, S, E); } SEAM(9);
    if (IN(10)) {
        for (int r4 = gw; r4 < MP / 8; r4 += ngw) {
            u32x4 raw[8][2]; float s[8];
#pragma unroll
            for (int q = 0; q < 8; ++q)
#pragma unroll
                for (int j = 0; j < 2; ++j) raw[q][j] = *(const u32x4*)(X3B + (size_t)(8 * r4 + q) * DM + 512 * j + 8 * lane);
            f32x4 w[4];
#pragma unroll
            for (int j = 0; j < 2; ++j) { w[2 * j] = *(const f32x4*)(fnw + 512 * j + 8 * lane); w[2 * j + 1] = *(const f32x4*)(fnw + 512 * j + 8 * lane + 4); }
#pragma unroll
            for (int q = 0; q < 8; ++q) { s[q] = 0.f;
#pragma unroll
                for (int j = 0; j < 2; ++j)
#pragma unroll
                    for (int e = 0; e < 4; ++e) { const unsigned u = raw[q][j][e]; const float a = __uint_as_float(u << 16), b = __uint_as_float(u & 0xffff0000u); s[q] += a * a + b * b; } }
#pragma unroll
            for (int o = 1; o < 64; o <<= 1) {
#pragma unroll
                for (int q = 0; q < 8; ++q) s[q] += __shfl_xor(s[q], o); }
#pragma unroll
            for (int q = 0; q < 8; ++q) { const float rstd = 1.0f / sqrtf(s[q] * (1.f / 1024.f) + EPS);
#pragma unroll
                for (int j = 0; j < 2; ++j) { const u32x4 u = raw[q][j];
                    const f32x4 v0 = (f32x4){__uint_as_float(u.x << 16), __uint_as_float(u.x & 0xffff0000u), __uint_as_float(u.y << 16), __uint_as_float(u.y & 0xffff0000u)};
                    const f32x4 v1 = (f32x4){__uint_as_float(u.z << 16), __uint_as_float(u.z & 0xffff0000u), __uint_as_float(u.w << 16), __uint_as_float(u.w & 0xffff0000u)};
                    float* op = out + O_YP + (size_t)(8 * r4 + q) * DM + 512 * j + 8 * lane;
                    *(f32x4*)op = v0 * rstd * w[2 * j]; *(f32x4*)(op + 4) = v1 * rstd * w[2 * j + 1]; } }
        }
        rms_rows_1024(Rows2{X3 + (size_t)MP * DM, X3 + (size_t)MP * DM, MS, DM}, fnw, out + O_YS, MS);
    }
#undef IN
#undef SEAM
}
#undef lds
#undef ldsl
#undef MISC
#undef tid
#undef lane
#undef wave
#undef gtid
#undef gthr
#undef gw
#undef ngw
#undef x_p
#undef x_s
#undef cache_kv
#undef cache_pe
#undef state_gla
#undef page_table
#undef f1n
#undef f1g
#undef f1u
#undef f1d
#undef mixn
#undef w_in
#undef w_a_up
#undef b_a
#undef gnw
#undef qnw
#undef w_uq
#undef kvnw
#undef w_uk
#undef w_uv
#undef w_out
#undef f2n
#undef f2g
#undef f2u
#undef f2d
#undef fnw
#undef WGU1
#undef WD1
#undef WIN
#undef WOUT
#undef WGU2
#undef WD2
#undef XB
#undef SSQ0
#undef H
#undef X1
#undef X1B
#undef SSQ1
#undef X2
#undef X2B
#undef SSQ2
#undef X3
#undef X3B
#undef SSQ3
#undef YMIXB
#undef PROJ
#undef OG
#undef QF
#undef LAT
#undef KPE
#undef KN
#undef VV
#undef CQN
#undef QLAT
#undef OLAT
#undef WQA
#undef RT
#undef CQB
#undef CQS
#undef CKV
#undef KPR
#undef KL
#undef QA
#undef QG
#undef KG
#undef VT
#undef VS
#undef SG
#undef ALOW
#undef DEC
#undef UT
#undef ST
#undef PART

extern "C" void kernel_launch(void* const* d_in, const int* in_sizes, int n_in, void* d_out, int out_size, void* d_ws, size_t ws_size, hipStream_t stream) {
    static int grid = 0;
    if (grid == 0) {
        if (n_in != 26 || (size_t)out_size != O_END || ws_size < B_END) { fprintf(stderr, "kernel_launch: unexpected sizes n_in %d out %d ws %zu (need %zu)\n", n_in, out_size, ws_size, (size_t)B_END); grid = -1; return; }
        int dev = 0, cus = 0;
        if (hipGetDevice(&dev) != hipSuccess || hipDeviceGetAttribute(&cus, hipDeviceAttributeMultiprocessorCount, dev) != hipSuccess) { grid = -1; return; }
        if (hipFuncSetAttribute((const void*)fwd_kernel, hipFuncAttributeMaxDynamicSharedMemorySize, LDS_BYTES) != hipSuccess) { fprintf(stderr, "hipFuncSetAttribute failed\n"); grid = -1; return; }
        int per_cu = 0;
        if (hipOccupancyMaxActiveBlocksPerMultiprocessor(&per_cu, (const void*)fwd_kernel, NTHR, LDS_BYTES) != hipSuccess || per_cu < 1) fprintf(stderr, "occupancy query: %d\n", per_cu);
        (void)hipGetLastError();
        grid = cus;
    }
    if (grid < 0) return;
    (void)hipMemsetAsync(d_ws, 0, WS_CTL_BYTES, stream);
    Args a{};
    for (int i = 0; i < 26; ++i) a.in[i] = d_in[i];
    a.out = (float*)d_out; a.ws = (unsigned char*)d_ws; a.pad = 0;
#if MK_ONE_LAUNCH
    a.ph_lo = 0; a.ph_hi = NPHASE; a.one = 1;
    hipLaunchKernelGGL(fwd_kernel, dim3(grid), dim3(NTHR), LDS_BYTES, stream, a);
#else
    for (int p = 0; p < NPHASE; ++p) { a.ph_lo = p; a.ph_hi = p + 1; a.one = 0; hipLaunchKernelGGL(fwd_kernel, dim3(grid), dim3(NTHR), LDS_BYTES, stream, a); }
#endif
}
```
